# Optimizing an MI355X kernel written in HIP

```python
import math
import jax, jax.numpy as jnp
from jax import lax
import numpy as np

D_MODEL = 1024
BATCH = 8
SEQ = 2048
DEPTH = 2

HEAD_DIM = 64
BLOCK = 128
A_Q_HEADS = 8
A_KV_HEADS = 2
A_WINDOW = 128
B_PATTERNS = ((128, 1), (512, 4), (2048, 16))
B_HEADS = 8
C_HEADS = 4
C_DK = 64
C_DV = 128
C_GATE_RANK = 16
C_GATE_TAU = 16.0
C_CHUNK = 64
BRANCH_WIDTH = 512
N_BRANCHES = 3
N_BUCKETS = 32
BUCKET_MAX_DIST = 2048
N_BIAS_HEADS = A_Q_HEADS + len(B_PATTERNS) * B_HEADS
PEER_HEADS = 8
PEER_KEYS = 128
PEER_N_EXPERTS = PEER_KEYS * PEER_KEYS
PEER_TOPK = 16
PEER_DKEY = 256
PEER_TOKEN_BLOCK = 128
RMS_EPS = 1e-6
NEG_INF = -1e30

IN_SIZES = (
    A_Q_HEADS * HEAD_DIM, A_KV_HEADS * HEAD_DIM, A_KV_HEADS * HEAD_DIM,
    B_HEADS * HEAD_DIM, B_HEADS * HEAD_DIM, B_HEADS * HEAD_DIM,
    B_HEADS * HEAD_DIM, B_HEADS * HEAD_DIM, B_HEADS * HEAD_DIM,
    B_HEADS * HEAD_DIM, B_HEADS * HEAD_DIM, B_HEADS * HEAD_DIM,
    C_HEADS * C_DK, C_HEADS * C_DK, C_HEADS * C_DV, C_GATE_RANK, C_HEADS * C_DV,
    N_BRANCHES * D_MODEL,
)
IN_WIDTH = sum(IN_SIZES)
SPLIT_POINTS = tuple(int(v) for v in np.cumsum(IN_SIZES)[:-1])

kernel_name = 'hybrid_swa_dilated_gla_peer_block'


def rmsnorm(x, g):
    xf = x.astype(jnp.float32)
    y = xf * lax.rsqrt(jnp.mean(xf * xf, axis=-1, keepdims=True) + RMS_EPS)
    return (y * g.astype(jnp.float32)).astype(x.dtype)


def t5_bucket(dist):
    max_exact = N_BUCKETS // 2
    large = max_exact + (jnp.log(jnp.maximum(dist, 1).astype(jnp.float32) / max_exact)
                         / math.log(BUCKET_MAX_DIST / max_exact) * (N_BUCKETS - max_exact)).astype(jnp.int32)
    large = jnp.minimum(large, N_BUCKETS - 1)
    return jnp.where(dist < max_exact, dist, large)


def rel_bias(table_cols, dilation):
    qi = jnp.arange(BLOCK)[:, None]
    kj = jnp.arange(2 * BLOCK)[None, :]
    dist = jnp.maximum(qi + BLOCK - kj, 0) * dilation
    return jnp.moveaxis(table_cols[t5_bucket(dist)], -1, 0).astype(jnp.float32)


def banded_attention(q, k, v, bias, max_dist, sink):
    n, length, hkv, grp, hd = q.shape
    nb = -(-length // BLOCK)
    pad = nb * BLOCK - length
    qb = jnp.pad(q, ((0, 0), (0, pad), (0, 0), (0, 0), (0, 0))).reshape(n, nb, BLOCK, hkv, grp, hd)

    def band(t):
        t = jnp.pad(t, ((0, 0), (BLOCK, pad), (0, 0), (0, 0))).reshape(n, nb + 1, BLOCK, hkv, hd)
        return jnp.concatenate([t[:, :-1], t[:, 1:]], axis=2)

    kb, vb = band(k), band(v)
    s = jnp.einsum('nbqhgd,nbkhd->nhgbqk', qb, kb, preferred_element_type=jnp.float32) * (hd ** -0.5)
    qi = jnp.arange(BLOCK)[:, None]
    kj = jnp.arange(2 * BLOCK)[None, :]
    dist = qi + BLOCK - kj
    in_window = (dist >= 0) & (dist <= max_dist)
    key_ok = (jnp.arange(nb)[:, None] * BLOCK - BLOCK + kj) >= 0
    mask = in_window[None] & key_ok[:, None, :]
    s = jnp.where(mask, s + bias[None, :, :, None], NEG_INF)
    m = s.max(-1)
    if sink is not None:
        sk = sink.astype(jnp.float32)[None, :, :, None, None]
        m = jnp.maximum(m, sk)
    p = jnp.exp(s - m[..., None])
    denom = p.sum(-1)
    if sink is not None:
        denom = denom + jnp.exp(sk - m)
    o = jnp.einsum('nhgbqk,nbkhd->nbqhgd', p.astype(v.dtype), vb, preferred_element_type=jnp.float32)
    o = o / jnp.transpose(denom, (0, 3, 4, 1, 2))[..., None]
    o = o.reshape(n, nb * BLOCK, hkv, grp, hd)[:, :length]
    lse = jnp.transpose(m + jnp.log(denom), (0, 3, 4, 1, 2)).reshape(n, nb * BLOCK, hkv, grp)[:, :length]
    return o, lse


def sliding_window_gqa(q, k, v, bias, sink):
    b, s, _ = q.shape
    grp = A_Q_HEADS // A_KV_HEADS
    o, _ = banded_attention(q.reshape(b, s, A_KV_HEADS, grp, HEAD_DIM),
                            k.reshape(b, s, A_KV_HEADS, HEAD_DIM),
                            v.reshape(b, s, A_KV_HEADS, HEAD_DIM),
                            bias, A_WINDOW - 1, sink.reshape(A_KV_HEADS, grp))
    return o.reshape(b, s, A_Q_HEADS * HEAD_DIM)


def dilated_attention(groups, biases):
    outs, lses = [], []
    for (window, dil), (q, k, v), bias in zip(B_PATTERNS, groups, biases):
        b, s, _ = q.shape
        sub = s // dil

        def to_sub(t, extra):
            t = t.reshape(b, sub, dil, B_HEADS, HEAD_DIM).transpose(0, 2, 1, 3, 4)
            return t.reshape((b * dil, sub, B_HEADS) + extra + (HEAD_DIM,))

        o, lse = banded_attention(to_sub(q, (1,)), to_sub(k, ()), to_sub(v, ()), bias, window // dil, None)
        outs.append(o.reshape(b, dil, sub, B_HEADS, HEAD_DIM).transpose(0, 2, 1, 3, 4).reshape(b, s, B_HEADS, HEAD_DIM))
        lses.append(lse.reshape(b, dil, sub, B_HEADS).transpose(0, 2, 1, 3).reshape(b, s, B_HEADS))
    w = jax.nn.softmax(jnp.stack(lses), axis=0)
    o = jnp.einsum('pbsh,pbshd->bshd', w, jnp.stack(outs))
    return o.reshape(o.shape[0], o.shape[1], B_HEADS * HEAD_DIM)


def gla_branch(q, k, v, z, r, head_norm):
    b, s, _ = q.shape
    nc = s // C_CHUNK

    def chunks(t, d):
        return t.reshape(b, nc, C_CHUNK, C_HEADS, d)

    q = chunks(q, C_DK) * (C_DK ** -0.5)
    k = chunks(k, C_DK)
    v = chunks(v, C_DV)
    log_a = chunks(jax.nn.log_sigmoid(z.astype(jnp.float32)) / C_GATE_TAU, C_DK)
    cum = jnp.cumsum(log_a, axis=2)
    last = cum[:, :, -1:]
    q_dec = q * jnp.exp(cum)
    k_inv = k * jnp.exp(-cum)
    k_end = k * jnp.exp(last - cum)
    causal = jnp.tril(jnp.ones((C_CHUNK, C_CHUNK), dtype=bool))
    att = jnp.where(causal, jnp.einsum('bnthd,bnshd->bnhts', q_dec, k_inv), 0.0)
    o_intra = jnp.einsum('bnhts,bnshv->bnthv', att, v)
    kv = jnp.einsum('bnshd,bnshv->nbhdv', k_end, v)
    decay = jnp.exp(jnp.moveaxis(last[:, :, 0], 1, 0))

    def step(state, inp):
        kv_n, dec_n = inp
        return state * dec_n[..., None] + kv_n, state

    _, s_prev = lax.scan(step, jnp.zeros((b, C_HEADS, C_DK, C_DV), jnp.float32), (kv, decay))
    o_inter = jnp.einsum('bnthd,nbhdv->bnthv', q_dec, s_prev)
    o = rmsnorm((o_intra + o_inter).reshape(b, s, C_HEADS, C_DV), head_norm)
    o = o * jax.nn.silu(r.astype(jnp.float32)).reshape(b, s, C_HEADS, C_DV)
    return o.reshape(b, s, C_HEADS * C_DV)


def peer_ffn(x, w_q, sub_keys, u_table, v_table):
    b, s, d = x.shape
    xt = x.reshape(-1, PEER_TOKEN_BLOCK, d)

    def block(xb):
        qy = (xb @ w_q).reshape(PEER_TOKEN_BLOCK, PEER_HEADS, 2, PEER_DKEY // 2)
        sc = jnp.einsum('thpc,hpnc->thpn', qy, sub_keys)
        s1, i1 = lax.top_k(sc[:, :, 0], PEER_TOPK)
        s2, i2 = lax.top_k(sc[:, :, 1], PEER_TOPK)
        cand_s = (s1[..., :, None] + s2[..., None, :]).reshape(PEER_TOKEN_BLOCK, PEER_HEADS, PEER_TOPK * PEER_TOPK)
        cand_i = (i1[..., :, None] * PEER_KEYS + i2[..., None, :]).reshape(PEER_TOKEN_BLOCK, PEER_HEADS, PEER_TOPK * PEER_TOPK)
        top_s, pos = lax.top_k(cand_s, PEER_TOPK)
        idx = jnp.take_along_axis(cand_i, pos, axis=-1)
        gate = jax.nn.softmax(top_s.astype(jnp.float32), axis=-1)
        hid = jax.nn.gelu(jnp.einsum('thkd,td->thk', u_table[idx], xb))
        return jnp.einsum('thk,thkd->td', (gate * hid).astype(xb.dtype), v_table[idx])

    return lax.map(block, xt).reshape(b, s, d)


def setup_inputs(seed: int = 0) -> dict:
    key = jax.random.key(seed)
    ks = jax.random.split(key, 16)

    def nrm(k, shape, scale):
        return jax.random.normal(k, shape, jnp.float32) * scale

    return {
        'x': nrm(ks[0], (BATCH, SEQ, D_MODEL), 1.0),
        'w_in': nrm(ks[1], (DEPTH, D_MODEL, IN_WIDTH), D_MODEL ** -0.5),
        'attn_sinks': nrm(ks[2], (DEPTH, A_Q_HEADS), 0.5),
        'gla_alpha_w': nrm(ks[3], (DEPTH, C_GATE_RANK, C_HEADS * C_DK), C_GATE_RANK ** -0.5),
        'gla_alpha_b': nrm(ks[4], (DEPTH, C_HEADS * C_DK), 0.1),
        'gla_head_norm': 1.0 + nrm(ks[5], (DEPTH, C_DV), 0.02),
        'w_branch': nrm(ks[6], (DEPTH, N_BRANCHES, BRANCH_WIDTH, D_MODEL), BRANCH_WIDTH ** -0.5),
        'w_out': nrm(ks[7], (DEPTH, D_MODEL, D_MODEL), D_MODEL ** -0.5),
        'norm_mix': 1.0 + nrm(ks[8], (DEPTH, D_MODEL), 0.02),
        'norm_ffn': 1.0 + nrm(ks[9], (DEPTH, D_MODEL), 0.02),
        'peer_wq': nrm(ks[10], (DEPTH, D_MODEL, PEER_HEADS * PEER_DKEY), D_MODEL ** -0.5),
        'peer_keys': nrm(ks[11], (DEPTH, PEER_HEADS, 2, PEER_KEYS, PEER_DKEY // 2), (PEER_DKEY // 2) ** -0.5),
        'peer_u': nrm(ks[12], (DEPTH, PEER_N_EXPERTS, D_MODEL), D_MODEL ** -0.5),
        'peer_v': nrm(ks[13], (DEPTH, PEER_N_EXPERTS, D_MODEL), PEER_TOPK ** -0.5),
        'rel_bias_table': nrm(ks[14], (N_BUCKETS, N_BIAS_HEADS), 0.5),
        'norm_final': 1.0 + nrm(ks[15], (D_MODEL,), 0.02),
    }


def reference(x, w_in, attn_sinks, gla_alpha_w, gla_alpha_b, gla_head_norm, w_branch, w_out,
              norm_mix, norm_ffn, peer_wq, peer_keys, peer_u, peer_v, rel_bias_table, norm_final):
    b, s, _ = x.shape
    bias_a = rel_bias(rel_bias_table[:, :A_Q_HEADS], 1).reshape(
        A_KV_HEADS, A_Q_HEADS // A_KV_HEADS, BLOCK, 2 * BLOCK)
    bias_b = [rel_bias(rel_bias_table[:, A_Q_HEADS + i * B_HEADS:A_Q_HEADS + (i + 1) * B_HEADS], dil).reshape(
        B_HEADS, 1, BLOCK, 2 * BLOCK) for i, (_, dil) in enumerate(B_PATTERNS)]
    for l in range(DEPTH):
        h = rmsnorm(x, norm_mix[l])
        parts = jnp.split(h @ w_in[l], SPLIT_POINTS, axis=-1)
        qa, ka, va = parts[0], parts[1], parts[2]
        b_groups = [(parts[3 + 3 * i], parts[4 + 3 * i], parts[5 + 3 * i]) for i in range(len(B_PATTERNS))]
        qc, kc, vc, alr, rc, gates = parts[12], parts[13], parts[14], parts[15], parts[16], parts[17]
        o_a = sliding_window_gqa(qa, ka, va, bias_a, attn_sinks[l])
        o_b = dilated_attention(b_groups, bias_b)
        o_c = gla_branch(qc, kc, vc, alr @ gla_alpha_w[l] + gla_alpha_b[l], rc, gla_head_norm[l])
        branches = jnp.stack([o_a, o_b, o_c], axis=2).astype(x.dtype)
        proj = jnp.einsum('bsnc,ncd->bsnd', branches, w_branch[l])
        merged = (jax.nn.sigmoid(gates.reshape(b, s, N_BRANCHES, D_MODEL)) * proj).sum(axis=2)
        x = x + merged @ w_out[l]
        x = x + peer_ffn(rmsnorm(x, norm_ffn[l]), peer_wq[l], peer_keys[l], peer_u[l], peer_v[l])
    return rmsnorm(x, norm_final)
```

```cpp
#include <hip/hip_runtime.h>
#include <cstdio>
#include <cstdint>

#define LAS __attribute__((address_space(3)))
typedef unsigned short bf16_t;
typedef short bf16x8 __attribute__((ext_vector_type(8)));
typedef float f32x4 __attribute__((ext_vector_type(4)));
typedef float f32x2 __attribute__((ext_vector_type(2)));
typedef unsigned u32x4 __attribute__((ext_vector_type(4)));
typedef unsigned u32x2 __attribute__((ext_vector_type(2)));

constexpr int T_TOK = 16384, DM = 1024, SEQ = 2048, NBATCH = 8, NLAYER = 2;
constexpr int NP = 10240;
constexpr int C_QA = 0, C_KA = 512, C_VA = 640;
constexpr int C_B0 = 768;
constexpr int C_QC = 5376, C_KC = 5632, C_VC = 5888, C_RC = 6400, C_Z = 6912, C_G = 7168;
constexpr int IN_W = 10000;
constexpr int NEXP = 16384;

constexpr size_t WS_CTL   = 0;
constexpr size_t CTL_BYTES = 65536;
constexpr size_t WS_LUT   = WS_CTL + CTL_BYTES;
constexpr size_t WS_DECAY = WS_LUT + 32768;
constexpr size_t WS_LSE   = WS_DECAY + 262144;
constexpr size_t WS_USC   = WS_LSE + 1572864;
constexpr size_t WS_VSC   = WS_USC + 131072;
constexpr size_t WS_P     = WS_VSC + 131072;
constexpr size_t WS_H     = WS_P + (size_t)T_TOK * NP * 2;
constexpr size_t WS_SPREV = WS_H + (size_t)T_TOK * DM * 2;
constexpr size_t WS_WIN   = WS_SPREV + 16777216;
constexpr size_t WS_WBR   = WS_WIN + (size_t)2 * NP * 1024 * 2;
constexpr size_t WS_WOUT  = WS_WBR + (size_t)2 * 3 * 1024 * 512 * 2;
constexpr size_t WS_WQ    = WS_WOUT + (size_t)2 * 1024 * 1024 * 2;
constexpr size_t WS_KEYS  = WS_WQ + (size_t)2 * 2048 * 1024 * 2;
constexpr size_t WS_U8    = WS_KEYS + (size_t)2 * 8 * 2 * 128 * 128 * 2;
constexpr size_t WS_V8    = WS_U8 + (size_t)2 * NEXP * 1024;
constexpr size_t WS_END   = WS_V8 + (size_t)2 * NEXP * 1024;
constexpr size_t WS_QY    = WS_P;
constexpr size_t WS_IDX   = WS_QY + (size_t)T_TOK * 2048 * 2;
constexpr size_t WS_GATE  = WS_IDX + (size_t)T_TOK * 128 * 4;
constexpr size_t WS_HIDP  = WS_GATE + (size_t)T_TOK * 128 * 4;
static_assert(WS_HIDP + (size_t)T_TOK * 128 * 8 * 4 <= WS_H, "peer alias");
static_assert(WS_END <= (size_t)536870912, "workspace");

constexpr int LDS_BYTES = 147456;
constexpr int LDS_MISC = 131072;

struct Params {
    const float *x, *w_in, *sinks, *alpha_w, *alpha_b, *head_norm, *w_branch, *w_out, *norm_mix, *norm_ffn, *peer_wq, *peer_keys, *peer_u, *peer_v, *rel_bias, *norm_final;
    float* out; unsigned char* ws; int ph_lo, ph_hi;
};

__device__ __forceinline__ float bf2f(unsigned short b) { return __uint_as_float(((unsigned)b) << 16); }
__device__ __forceinline__ float bflo(unsigned u) { return __uint_as_float(u << 16); }
__device__ __forceinline__ float bfhi(unsigned u) { return __uint_as_float(u & 0xffff0000u); }
__device__ __forceinline__ unsigned cvt_pk_bf16(float lo, float hi) { unsigned r; asm("v_cvt_pk_bf16_f32 %0, %1, %2" : "=v"(r) : "v"(lo), "v"(hi)); return r; }
__device__ __forceinline__ float fexp(float x) { return __builtin_amdgcn_exp2f(x * 1.4426950408889634f); }
__device__ __forceinline__ float flog(float x) { return __builtin_amdgcn_logf(x) * 0.6931471805599453f; }
__device__ __forceinline__ float fsigmoid(float x) { return __builtin_amdgcn_rcpf(1.0f + fexp(-x)); }
__device__ __forceinline__ float flogsigmoid(float z) { return fminf(z, 0.f) - flog(1.0f + fexp(-fabsf(z))); }
__device__ __forceinline__ float fgelu_tanh(float x) { const float u = 0.7978845608028654f * (x + 0.044715f * x * x * x); return x * fsigmoid(2.0f * u); }
__device__ __forceinline__ float wave_sum(float v) {
#pragma unroll
    for (int o = 32; o >= 1; o >>= 1) v += __shfl_xor(v, o);
    return v;
}
__device__ __forceinline__ float wave_max(float v) {
#pragma unroll
    for (int o = 32; o >= 1; o >>= 1) v = fmaxf(v, __shfl_xor(v, o));
    return v;
}
#define WG_SYNC() __syncthreads()
__device__ __forceinline__ int opaque_tid() { int t = (int)threadIdx.x; asm volatile("" : "+v"(t)); return t; }


#define XB_TMO      128
#define XB_XCNT(j)  (256  + 64 * (j))
#define XB_XSUB(j)  (1280 + 64 * (j))
#define XB_XGEN(j)  (2304 + 64 * (j))
#define XB_TOP      3328
#define XB_TOPGEN   3392
#define XCD_BAR_WORDS 3456
#define XB_SPIN_CAP (1u << 18)

__device__ __forceinline__ unsigned xb_ld(unsigned* p)              { return __hip_atomic_load(p, __ATOMIC_RELAXED, __HIP_MEMORY_SCOPE_AGENT); }
__device__ __forceinline__ unsigned xb_add(unsigned* p, unsigned v) { return __hip_atomic_fetch_add(p, v, __ATOMIC_RELAXED, __HIP_MEMORY_SCOPE_AGENT); }
__device__ __forceinline__ unsigned xb_xcc_id() { return (unsigned)__builtin_amdgcn_s_getreg((3 << 11) | 20) & 0xFu; }
#define XB_SPIN(cond, bar) do { unsigned _sp = 0; while (cond) { __builtin_amdgcn_s_sleep(1); \
    if ((++_sp & 255u) == 0u) { if (xb_ld(&(bar)[XB_TMO])) break; if (_sp > XB_SPIN_CAP) { atomicAdd(&(bar)[XB_TMO], 1u); break; } } } } while (0)

struct XcdBarrier {
    unsigned* bar; unsigned x;
    volatile LAS unsigned* st;
};

__device__ __forceinline__ XcdBarrier xcd_barrier_post(unsigned* bar, volatile LAS unsigned* st) {
    XcdBarrier b; b.bar = bar; b.x = xb_xcc_id(); b.st = st;
    if (threadIdx.x == 0) (void)xb_add(&bar[XB_XCNT(b.x)], 1u);
    return b;
}
__device__ __forceinline__ void xcd_barrier_complete(unsigned* bar, unsigned x, unsigned& nloc, unsigned& nx) {
    const unsigned G = gridDim.x * gridDim.y * gridDim.z;
    unsigned sum, cnt, mine, sp = 0u;
    for (;;) {
        sum = 0u; cnt = 0u; mine = 0u;
#pragma unroll
        for (unsigned j = 0; j < 16; ++j) { const unsigned c = xb_ld(&bar[XB_XCNT(j)]); sum += c; cnt += (c > 0u) ? 1u : 0u; mine = (j == x) ? c : mine; }
        if (sum == G) break;
        __builtin_amdgcn_s_sleep(1);
        if ((++sp & 255u) == 0u) { if (xb_ld(&bar[XB_TMO])) break; if (sp > XB_SPIN_CAP) { atomicAdd(&bar[XB_TMO], 1u); break; } }
    }
    nloc = mine > 0u ? mine : 1u; nx = cnt > 0u ? cnt : 1u;
}

__device__ __forceinline__ void xcd_barrier(const XcdBarrier& b) {
    asm volatile("s_waitcnt vmcnt(0)" ::: "memory");
    __syncthreads();
    if (threadIdx.x == 0) {
        unsigned* bar = b.bar;
        __builtin_amdgcn_s_waitcnt(0);
        unsigned nloc = b.st[0], nx = b.st[1];
        if (nloc == 0u) { xcd_barrier_complete(bar, b.x, nloc, nx); b.st[0] = nloc; b.st[1] = nx; }
        const unsigned old = xb_add(&bar[XB_XSUB(b.x)], 1u);
        const unsigned gen = old / nloc;
        if (old + 1u == (gen + 1u) * nloc) {
            __builtin_amdgcn_fence(__ATOMIC_RELEASE, "agent");
            asm volatile("s_waitcnt vmcnt(0)" ::: "memory");
            const unsigned og = xb_add(&bar[XB_TOP], 1u);
            const unsigned tg = og / nx;
            if (og + 1u == (tg + 1u) * nx) xb_add(&bar[XB_TOPGEN], 1u);
            else XB_SPIN(xb_ld(&bar[XB_TOPGEN]) == tg, bar);
            __builtin_amdgcn_fence(__ATOMIC_ACQUIRE, "agent");
            xb_add(&bar[XB_XGEN(b.x)], 1u);
            asm volatile("s_waitcnt vmcnt(0)" ::: "memory");
        } else {
            XB_SPIN(xb_ld(&bar[XB_XGEN(b.x)]) == gen, bar);
            __builtin_amdgcn_fence(__ATOMIC_ACQUIRE, "agent");
            asm volatile("s_waitcnt vmcnt(0)" ::: "memory");
        }
    }
    __syncthreads();
}

namespace pg8 {
#define PG8_LAS __attribute__((address_space(3)))
constexpr int BM = 256, BK = 64, HALF = 128, HTB = HALF * BK * 2  , STAGE_BYTES = 8 * HTB, NXCD = 8, WGM = 8;

__host__ __device__ __forceinline__ int lds_byte(int r, int c) { const int st = (r >> 4) * 2 + (c >> 5), rr = r & 15, cc = c & 31, ob = rr * 64 + cc * 2; return st * 1024 + (ob ^ (((ob >> 9) & 1) << 5)); }
__host__ __device__ __forceinline__ void stage_rc(int b, int& R, int& C) { const int st = b / 1024, sb = b % 1024, swz = sb ^ (((sb >> 9) & 1) << 5); R = (st >> 1) * 16 + swz / 64; C = (st & 1) * 32 + (swz % 64) / 2; }
__host__ __device__ __forceinline__ int perm32(int rho) { const int n = rho >> 4, i = rho & 15; return 8 * (i >> 2) + 4 * n + (i & 3); }

struct Unit { int pm, pn, z; };
struct Gemm { const bf16_t* A; const bf16_t* Bt; int M, N, K, lda, ldb; };

struct StaticOrder {
    int nM, nN, nwg, G, c;
    __host__ __device__ void init(int M, int N, int G_, int c_) { nM = M / BM; nN = N / BM; nwg = nM * nN; G = G_; c = c_; }
    __host__ __device__ bool next(int i, Unit& u) const {
        const long L = (long)i * G + c; if (L >= nwg) return false;
        int wgid = (int)L; { const int q = nwg / NXCD, r = nwg % NXCD, xcd = wgid % NXCD, off = wgid / NXCD; wgid = (xcd < r ? xcd * (q + 1) : r * (q + 1) + (xcd - r) * q) + off; }
        const int nig = WGM * nN, gid = wgid / nig, fm = gid * WGM, gsz = (nM - fm) < WGM ? (nM - fm) : WGM;
        u.pm = fm + ((wgid % nig) % gsz); u.pn = (wgid % nig) / gsz; u.z = 0; return true;
    }
    __device__ __forceinline__ const char* ptrA(const Gemm& g, const Unit& u) const { return (const char*)g.A + (size_t)u.pm * BM * g.lda * 2; }
    __device__ __forceinline__ const char* ptrB(const Gemm& g, const Unit& u) const { return (const char*)g.Bt + (size_t)u.pn * BM * g.ldb * 2; }
    __device__ __forceinline__ void a_ready(const Unit&) const {}
    __device__ __forceinline__ void done(const Unit&) const {}
};


struct EpiIn {
    static constexpr bool PERM = true, AFTER_DRAIN = false;
    bf16_t* O; const float* zbias;
    __device__ __forceinline__ void operator()(const f32x4 (&acc)[2][2][4][2], const Unit& u, int wr, int wc, int fr, int fq) const {
        const int row0 = u.pm * BM + wr * 64 + fr; const int cin = wc * 32 + 8 * fq; const int col0 = u.pn * BM + cin;
        const int mode = (u.pn >= 28) ? 2 : (u.pn == 27 ? 1 : 0);
        f32x4 bv[2][2];
#pragma unroll
        for (int bj = 0; bj < 2; ++bj)
#pragma unroll
            for (int n = 0; n < 2; ++n) bv[bj][n] = (mode == 1) ? *(const f32x4*)(zbias + cin + bj * HALF + 4 * n) : (f32x4){0.f, 0.f, 0.f, 0.f};
#pragma unroll
        for (int ai = 0; ai < 2; ++ai)
#pragma unroll
            for (int m = 0; m < 4; ++m) { bf16_t* rowp = O + (size_t)(row0 + ai * HALF + m * 16) * NP + col0;
#pragma unroll
                for (int bj = 0; bj < 2; ++bj) { f32x4 v0 = acc[ai][bj][m][0] + bv[bj][0], v1 = acc[ai][bj][m][1] + bv[bj][1];
                    if (mode == 2) {
#pragma unroll
                        for (int j = 0; j < 4; ++j) { v0[j] = fsigmoid(v0[j]); v1[j] = fsigmoid(v1[j]); } }
                    if (mode == 1) {
#pragma unroll
                        for (int j = 0; j < 4; ++j) { v0[j] = flogsigmoid(v0[j]) * 0.0625f; v1[j] = flogsigmoid(v1[j]) * 0.0625f; } }
                    u32x4 w; w.x = cvt_pk_bf16(v0[0], v0[1]); w.y = cvt_pk_bf16(v0[2], v0[3]); w.z = cvt_pk_bf16(v1[0], v1[1]); w.w = cvt_pk_bf16(v1[2], v1[3]);
                    *(u32x4*)(rowp + bj * HALF) = w; } }
    }
};
struct EpiBf {
    static constexpr bool PERM = true, AFTER_DRAIN = false;
    bf16_t* O; int ldc;
    __device__ __forceinline__ void operator()(const f32x4 (&acc)[2][2][4][2], const Unit& u, int wr, int wc, int fr, int fq) const {
        const int row0 = u.pm * BM + wr * 64 + fr; const int col0 = u.pn * BM + wc * 32 + 8 * fq;
#pragma unroll
        for (int ai = 0; ai < 2; ++ai)
#pragma unroll
            for (int m = 0; m < 4; ++m) { bf16_t* rowp = O + (size_t)(row0 + ai * HALF + m * 16) * ldc + col0;
#pragma unroll
                for (int bj = 0; bj < 2; ++bj) { const f32x4 v0 = acc[ai][bj][m][0], v1 = acc[ai][bj][m][1];
                    u32x4 w; w.x = cvt_pk_bf16(v0[0], v0[1]); w.y = cvt_pk_bf16(v0[2], v0[3]); w.z = cvt_pk_bf16(v1[0], v1[1]); w.w = cvt_pk_bf16(v1[2], v1[3]);
                    *(u32x4*)(rowp + bj * HALF) = w; } }
    }
};
struct EpiMerge {
    static constexpr bool PERM = true, AFTER_DRAIN = false;
    const bf16_t* Pm; bf16_t* MG;
    __device__ __forceinline__ void operator()(const f32x4 (&acc)[2][2][4][2], const Unit& u, int wr, int wc, int fr, int fq) const {
        const int row0 = u.pm * BM + wr * 64 + fr; const int col0 = u.pn * BM + wc * 32 + 8 * fq; const int z = u.z;
#pragma unroll
        for (int ai = 0; ai < 2; ++ai)
#pragma unroll
            for (int m = 0; m < 4; ++m) { const int row = row0 + ai * HALF + m * 16;
                const bf16_t* gp = Pm + (size_t)row * NP + C_G + 1024 * z + col0; bf16_t* mp = MG + (size_t)row * DM + col0;
#pragma unroll
                for (int bj = 0; bj < 2; ++bj) { const u32x4 gw = *(const u32x4*)(gp + bj * HALF); const f32x4 v0 = acc[ai][bj][m][0], v1 = acc[ai][bj][m][1];
                    float o[8];
                    o[0] = bflo(gw.x) * v0[0]; o[1] = bfhi(gw.x) * v0[1]; o[2] = bflo(gw.y) * v0[2]; o[3] = bfhi(gw.y) * v0[3];
                    o[4] = bflo(gw.z) * v1[0]; o[5] = bfhi(gw.z) * v1[1]; o[6] = bflo(gw.w) * v1[2]; o[7] = bfhi(gw.w) * v1[3];
                    if (z > 0) { const u32x4 pw = *(const u32x4*)(mp + bj * HALF);
                        o[0] += bflo(pw.x); o[1] += bfhi(pw.x); o[2] += bflo(pw.y); o[3] += bfhi(pw.y); o[4] += bflo(pw.z); o[5] += bfhi(pw.z); o[6] += bflo(pw.w); o[7] += bfhi(pw.w); }
                    u32x4 w; w.x = cvt_pk_bf16(o[0], o[1]); w.y = cvt_pk_bf16(o[2], o[3]); w.z = cvt_pk_bf16(o[4], o[5]); w.w = cvt_pk_bf16(o[6], o[7]);
                    *(u32x4*)(mp + bj * HALF) = w; } }
    }
};
struct EpiResid {
    static constexpr bool PERM = false, AFTER_DRAIN = false;
    const float* src; float* dst;
    __device__ __forceinline__ void operator()(const f32x4 (&acc)[2][2][4][2], const Unit& u, int wr, int wc, int fr, int fq) const {
        const int row0 = u.pm * BM + wr * 64 + fr, col0 = u.pn * BM + wc * 32 + 4 * fq;
#pragma unroll
        for (int ai = 0; ai < 2; ++ai)
#pragma unroll
            for (int m = 0; m < 4; ++m) { const size_t off = (size_t)(row0 + ai * HALF + m * 16) * DM + col0;
#pragma unroll
                for (int bj = 0; bj < 2; ++bj)
#pragma unroll
                    for (int n = 0; n < 2; ++n) { const f32x4 b = *(const f32x4*)(src + off + bj * HALF + n * 16); *(f32x4*)(dst + off + bj * HALF + n * 16) = b + acc[ai][bj][m][n]; } }
    }
};

template <class Epi, class Sched, bool STAMP = false>
__device__ __forceinline__ void gemm_phase(PG8_LAS unsigned char* lds, const Gemm g, const Sched& S, const Epi& E, unsigned long long* stamps) {
    const int tid = opaque_tid(), wid = __builtin_amdgcn_readfirstlane(tid >> 6), lane = tid & 63, wr = wid >> 2, wc = wid & 3, fr = lane & 15, fq = lane >> 4;
    const int K = g.K, nt = K / BK;
    int ts_lo = 0, ts_hi = 0, nts = 0; const unsigned long long rt_entry = STAMP ? (unsigned long long)wall_clock64() : 0ull;
#define PG8_STAMP() do { if (STAMP && wid == 0 && nts < 64) { const unsigned long long _c = (unsigned long long)clock64(); \
        ts_lo = (lane == nts) ? (int)(unsigned)_c : ts_lo; ts_hi = (lane == nts) ? (int)(unsigned)(_c >> 32) : ts_hi; ++nts; } } while (0)
    PG8_STAMP();
    unsigned voffA[2], voffB[2];
#pragma unroll
    for (int i = 0; i < 2; ++i) { int R, C; stage_rc(tid * 16 + i * 8192, R, C); const int Rb = Epi::PERM ? ((R & ~31) + perm32(R & 31)) : R;
        voffA[i] = (unsigned)(R * g.lda + C) * 2u; voffB[i] = (unsigned)(Rb * g.ldb + C) * 2u; }
    const size_t kstep = (size_t)(BK * 2);
    const size_t hstepA = (size_t)HALF * g.lda * 2, hstepB = (size_t)HALF * g.ldb * 2;
    const unsigned ldsw = (unsigned)wid * 1024u;
    const int aoff = lds_byte(wr * 64 + fr, fq * 8), boff = lds_byte(wc * 32 + fr, fq * 8);
#define PG8_SA(b, h) (((b) * 2 + (h)) * HTB)
#define PG8_SB(b, h) ((4 + (b) * 2 + (h)) * HTB)
#define PG8_STAGE(bufoff, gbase, voff) do { _Pragma("unroll") for (int _i = 0; _i < 2; ++_i) \
        __builtin_amdgcn_global_load_lds((const unsigned*)((const char*)(gbase) + (voff)[_i]), (PG8_LAS unsigned*)(lds + (bufoff) + ldsw + _i * 8192), 16, 0, 0); } while (0)
#define PG8_LDA(dst, b, h) do { _Pragma("unroll") for (int m = 0; m < 4; ++m) _Pragma("unroll") for (int k = 0; k < 2; ++k) dst[m][k] = *(const PG8_LAS bf16x8*)(lds + PG8_SA(b, h) + aoff + m * 2048 + k * 1024); } while (0)
#define PG8_LDB(dst, b, h) do { _Pragma("unroll") for (int n = 0; n < 2; ++n) _Pragma("unroll") for (int k = 0; k < 2; ++k) dst[n][k] = *(const PG8_LAS bf16x8*)(lds + PG8_SB(b, h) + boff + n * 2048 + k * 1024); } while (0)
#define PG8_MMA(ai, bj, At, Bt) do { __builtin_amdgcn_s_setprio(1); _Pragma("unroll") for (int m = 0; m < 4; ++m) _Pragma("unroll") for (int n = 0; n < 2; ++n) _Pragma("unroll") for (int k = 0; k < 2; ++k) \
        acc[ai][bj][m][n] = __builtin_amdgcn_mfma_f32_16x16x32_bf16(Bt[n][k], At[m][k], acc[ai][bj][m][n], 0, 0, 0); __builtin_amdgcn_s_setprio(0); } while (0)
#define PG8_WAIT_V(n) asm volatile("s_waitcnt vmcnt(" #n ")" ::: "memory")
#define PG8_WAIT_L(n) asm volatile("s_waitcnt lgkmcnt(" #n ")" ::: "memory")
#define PG8_BAR __builtin_amdgcn_s_barrier()
#define PG8_SCHED __builtin_amdgcn_sched_barrier(0)
    Unit cur, nxt; int ui = 0;
    if (!S.next(0, cur)) return;
    f32x4 acc[2][2][4][2];
#pragma unroll
    for (int a = 0; a < 2; ++a)
#pragma unroll
        for (int b = 0; b < 2; ++b)
#pragma unroll
            for (int m = 0; m < 4; ++m)
#pragma unroll
                for (int n = 0; n < 2; ++n) acc[a][b][m][n] = (f32x4){0.f, 0.f, 0.f, 0.f};
    bf16x8 At[4][2], B0[2][2], B1[2][2];
    const char* cA = S.ptrA(g, cur); const char* cB = S.ptrB(g, cur);
    S.a_ready(cur);
    PG8_STAGE(PG8_SB(0, 0), cB, voffB); PG8_STAGE(PG8_SA(0, 0), cA, voffA); PG8_STAGE(PG8_SB(0, 1), cB + hstepB, voffB); PG8_STAGE(PG8_SA(0, 1), cA + hstepA, voffA);
    if (wr == 1) PG8_BAR;
    PG8_WAIT_V(4); PG8_BAR;
    PG8_STAGE(PG8_SB(1, 0), cB + kstep, voffB); PG8_STAGE(PG8_SA(1, 0), cA + kstep, voffA); PG8_STAGE(PG8_SB(1, 1), cB + hstepB + kstep, voffB);
    PG8_WAIT_V(6); PG8_BAR;
    PG8_STAMP();
    for (;;) {
        const bool has_next = S.next(ui + 1, nxt);
        const char* nA = has_next ? S.ptrA(g, nxt) : cA; const char* nB = has_next ? S.ptrB(g, nxt) : cB;
        for (int t = 0; t < nt; t += 2) {
            const bool last = (t == nt - 2);
            const char* a1 = cA + (size_t)(t + 1) * kstep;
            const char* a2 = last ? nA : cA + (size_t)(t + 2) * kstep; const char* b2 = last ? nB : cB + (size_t)(t + 2) * kstep;
            const char* a3 = a2 + kstep; const char* b3 = b2 + kstep;
            if (last && has_next) S.a_ready(nxt);
            PG8_LDB(B0, 0, 0); PG8_SCHED; PG8_LDA(At, 0, 0); PG8_STAGE(PG8_SA(1, 1), a1 + hstepA, voffA);
            PG8_WAIT_L(8); PG8_BAR; PG8_WAIT_L(0); PG8_MMA(0, 0, At, B0); PG8_BAR; PG8_SCHED;
            PG8_LDB(B1, 0, 1); PG8_STAGE(PG8_SB(0, 0), b2, voffB);
            PG8_BAR; PG8_WAIT_L(0); PG8_MMA(0, 1, At, B1); PG8_BAR;
            PG8_LDA(At, 0, 1); PG8_STAGE(PG8_SA(0, 0), a2, voffA);
            PG8_BAR; PG8_WAIT_L(0); PG8_MMA(1, 0, At, B0); PG8_BAR; PG8_SCHED;
            PG8_STAGE(PG8_SB(0, 1), b2 + hstepB, voffB);
            PG8_WAIT_V(6); PG8_BAR; PG8_MMA(1, 1, At, B1); PG8_BAR;
            PG8_LDB(B0, 1, 0); PG8_SCHED; PG8_LDA(At, 1, 0); PG8_STAGE(PG8_SA(0, 1), a2 + hstepA, voffA);
            PG8_WAIT_L(8); PG8_BAR; PG8_WAIT_L(0); PG8_MMA(0, 0, At, B0); PG8_BAR; PG8_SCHED;
            PG8_LDB(B1, 1, 1); PG8_STAGE(PG8_SB(1, 0), b3, voffB);
            PG8_BAR; PG8_WAIT_L(0); PG8_MMA(0, 1, At, B1); PG8_BAR;
            PG8_LDA(At, 1, 1); PG8_STAGE(PG8_SA(1, 0), a3, voffA);
            PG8_BAR; PG8_WAIT_L(0); PG8_MMA(1, 0, At, B0); PG8_BAR; PG8_SCHED;
            PG8_STAGE(PG8_SB(1, 1), b3 + hstepB, voffB);
            PG8_WAIT_V(6); PG8_BAR; PG8_MMA(1, 1, At, B1); PG8_BAR;
        }
        PG8_STAMP();
        if constexpr (!Epi::AFTER_DRAIN) { E(acc, cur, wr, wc, fr, fq); S.done(cur); }
        PG8_STAMP();
        if (!has_next) break;
#pragma unroll
        for (int a = 0; a < 2; ++a)
#pragma unroll
            for (int b = 0; b < 2; ++b)
#pragma unroll
                for (int m = 0; m < 4; ++m)
#pragma unroll
                    for (int n = 0; n < 2; ++n) acc[a][b][m][n] = (f32x4){0.f, 0.f, 0.f, 0.f};
        cur = nxt; cA = nA; cB = nB; ++ui;
    }
    PG8_WAIT_V(0);
    if (wr == 0) PG8_BAR;
    PG8_BAR;
    if constexpr (Epi::AFTER_DRAIN) { E.fused(acc, cur, wr, wc, fr, fq, lds, wid, lane); S.done(cur); }
    PG8_STAMP();
    if (STAMP && wid == 0) { stamps[lane] = lane < nts ? (((unsigned long long)(unsigned)ts_hi << 32) | (unsigned)ts_lo) : 0ull;
        if (lane == 62) stamps[62] = rt_entry; if (lane == 63) stamps[63] = (unsigned long long)wall_clock64(); }
#undef PG8_STAMP
#undef PG8_SA
#undef PG8_SB
#undef PG8_STAGE
#undef PG8_LDA
#undef PG8_LDB
#undef PG8_MMA
#undef PG8_WAIT_V
#undef PG8_WAIT_L
#undef PG8_BAR
#undef PG8_SCHED
}
}

using pg8::Unit; using pg8::Gemm; using pg8::StaticOrder;

struct MergeOrder : StaticOrder {
    __device__ __forceinline__ bool next(int i, Unit& u) const { if (!StaticOrder::next(i / 3, u)) return false; u.z = i % 3; return true; }
    __device__ __forceinline__ const char* ptrA(const Gemm& g, const Unit& u) const { const int col = (u.z == 0) ? C_QA : (u.z == 1 ? C_B0 : C_VC); return (const char*)(g.A + col) + (size_t)u.pm * pg8::BM * g.lda * 2; }
    __device__ __forceinline__ const char* ptrB(const Gemm& g, const Unit& u) const { return (const char*)(g.Bt + (size_t)u.z * 1024 * 512) + (size_t)u.pn * pg8::BM * g.ldb * 2; }
};

template <bool OUT_BF16>
__device__ __forceinline__ void rmsnorm_phase(const float* src, const float* gain, void* dst, int G, int c) {
    const int tid = opaque_tid(), lane = tid & 63, wid = tid >> 6;
    f32x4 gv[4];
#pragma unroll
    for (int q = 0; q < 4; ++q) gv[q] = *(const f32x4*)(gain + 256 * q + 4 * lane);
    for (int row = c * 8 + wid; row < T_TOK; row += G * 8) {
        f32x4 v[4]; float ss = 0.f;
#pragma unroll
        for (int q = 0; q < 4; ++q) { v[q] = *(const f32x4*)(src + (size_t)row * DM + 256 * q + 4 * lane); ss += v[q][0] * v[q][0] + v[q][1] * v[q][1] + v[q][2] * v[q][2] + v[q][3] * v[q][3]; }
        ss = wave_sum(ss);
        const float r = __builtin_amdgcn_rsqf(ss * (1.0f / 1024.0f) + 1e-6f);
#pragma unroll
        for (int q = 0; q < 4; ++q) { const f32x4 y = v[q] * r * gv[q];
            if (OUT_BF16) { u32x2 w; w.x = cvt_pk_bf16(y[0], y[1]); w.y = cvt_pk_bf16(y[2], y[3]); *(u32x2*)((bf16_t*)dst + (size_t)row * DM + 256 * q + 4 * lane) = w; }
            else *(f32x4*)((float*)dst + (size_t)row * DM + 256 * q + 4 * lane) = y; }
    }
}

__device__ __forceinline__ void tile_write_out(LAS float* tile, bf16_t* dst, int ld_dst, int n0, int k0) {
    const int tid = opaque_tid(), n = tid >> 3, ks = tid & 7;
    float v[8];
#pragma unroll
    for (int e = 0; e < 8; ++e) v[e] = tile[(8 * ks + e) * 65 + n];
    u32x4 w; w.x = cvt_pk_bf16(v[0], v[1]); w.y = cvt_pk_bf16(v[2], v[3]); w.z = cvt_pk_bf16(v[4], v[5]); w.w = cvt_pk_bf16(v[6], v[7]);
    *(u32x4*)(dst + (size_t)(n0 + n) * ld_dst + k0 + 8 * ks) = w;
}
__device__ __forceinline__ void transpose_tile(LAS float* tile, const float* src, int ld_src, int src_col0, int k0, bf16_t* dst, int ld_dst, int n0) {
    const int tid = opaque_tid();
#pragma unroll
    for (int q = 0; q < 2; ++q) { const int row = (tid >> 4) + 32 * q, c4 = (tid & 15) * 4;
        const f32x4 v = *(const f32x4*)(src + (size_t)(k0 + row) * ld_src + src_col0 + c4);
        tile[row * 65 + c4] = v[0]; tile[row * 65 + c4 + 1] = v[1]; tile[row * 65 + c4 + 2] = v[2]; tile[row * 65 + c4 + 3] = v[3]; }
    WG_SYNC();
    tile_write_out(tile, dst, ld_dst, n0, k0);
    WG_SYNC();
}
__device__ __forceinline__ void prologue_phase(const Params& p, LAS unsigned char* L, int G, int c) {
    const int tid = opaque_tid(), lane = tid & 63, wid = tid >> 6;
    LAS float* tile = (LAS float*)L;
    unsigned char* ws = p.ws;
    for (int it = c; it < 7424; it += G) {
        if (it < 5120) { const int l = it / 2560, r = it % 2560, nt = r / 16, kt = r % 16, n0 = nt * 64, k0 = kt * 64;
            const float* src = p.w_in + (size_t)l * 1024 * IN_W; bf16_t* dst = (bf16_t*)(ws + WS_WIN) + (size_t)l * NP * 1024;
            if (n0 >= C_Z && n0 < C_G) {
                const int k = tid >> 3, nb = (tid & 7) * 8, j0 = n0 - C_Z + nb;
                float acc[8];
#pragma unroll
                for (int e = 0; e < 8; ++e) acc[e] = 0.f;
                const float* wr = src + (size_t)(k0 + k) * IN_W + 6400; const float* aw = p.alpha_w + (size_t)l * 16 * 256 + j0;
#pragma unroll
                for (int r2 = 0; r2 < 16; ++r2) { const float wv = wr[r2]; const f32x4 a0 = *(const f32x4*)(aw + r2 * 256), a1 = *(const f32x4*)(aw + r2 * 256 + 4);
                    acc[0] += wv * a0[0]; acc[1] += wv * a0[1]; acc[2] += wv * a0[2]; acc[3] += wv * a0[3]; acc[4] += wv * a1[0]; acc[5] += wv * a1[1]; acc[6] += wv * a1[2]; acc[7] += wv * a1[3]; }
#pragma unroll
                for (int e = 0; e < 8; ++e) tile[k * 65 + nb + e] = acc[e];
                WG_SYNC(); tile_write_out(tile, dst, 1024, n0, k0); WG_SYNC();
            } else { const int sc0 = (n0 < C_RC) ? n0 : (n0 < C_Z ? n0 + 16 : n0 - 240);
                transpose_tile(tile, src, IN_W, sc0, k0, dst, 1024, n0); }
        } else if (it < 5888) { const int q = it - 5120, ln = q / 128, r = q % 128, nt = r / 8, kt = r % 8;
            transpose_tile(tile, p.w_branch + (size_t)ln * 512 * 1024, 1024, nt * 64, kt * 64, (bf16_t*)(ws + WS_WBR) + (size_t)ln * 1024 * 512, 512, nt * 64);
        } else if (it < 6400) { const int q = it - 5888, l = q / 256, r = q % 256, nt = r / 16, kt = r % 16;
            transpose_tile(tile, p.w_out + (size_t)l * 1024 * 1024, 1024, nt * 64, kt * 64, (bf16_t*)(ws + WS_WOUT) + (size_t)l * 1024 * 1024, 1024, nt * 64);
        } else { const int q = it - 6400, l = q / 512, r = q % 512, nt = r / 16, kt = r % 16;
            transpose_tile(tile, p.peer_wq + (size_t)l * 1024 * 2048, 2048, nt * 64, kt * 64, (bf16_t*)(ws + WS_WQ) + (size_t)l * 2048 * 1024, 1024, nt * 64); }
    }
    for (int i = (c * 512 + tid) * 8; i < 2 * 8 * 2 * 128 * 128; i += G * 512 * 8) {
        const f32x4 a = *(const f32x4*)(p.peer_keys + i), b = *(const f32x4*)(p.peer_keys + i + 4);
        u32x4 w; w.x = cvt_pk_bf16(a[0], a[1]); w.y = cvt_pk_bf16(a[2], a[3]); w.z = cvt_pk_bf16(b[0], b[1]); w.w = cvt_pk_bf16(b[2], b[3]);
        *(u32x4*)((bf16_t*)(ws + WS_KEYS) + i) = w; }
    for (int row = c * 8 + wid; row < 4 * NEXP; row += G * 8) {
        const int tb = row / (2 * NEXP), rem = row % (2 * NEXP), l = rem / NEXP, e = rem % NEXP;
        const float* src = (tb ? p.peer_v : p.peer_u) + ((size_t)l * NEXP + e) * 1024 + 16 * lane;
        f32x4 v[4]; float am = 0.f;
#pragma unroll
        for (int q = 0; q < 4; ++q) { v[q] = *(const f32x4*)(src + 4 * q); am = fmaxf(am, fmaxf(fmaxf(fabsf(v[q][0]), fabsf(v[q][1])), fmaxf(fabsf(v[q][2]), fabsf(v[q][3])))); }
        am = wave_max(am);
        const float inv = am > 0.f ? 256.0f / am : 0.f;
        u32x4 w; unsigned ww[4];
#pragma unroll
        for (int q = 0; q < 4; ++q) { int pk = __builtin_amdgcn_cvt_pk_fp8_f32(v[q][0] * inv, v[q][1] * inv, 0, false); pk = __builtin_amdgcn_cvt_pk_fp8_f32(v[q][2] * inv, v[q][3] * inv, pk, true); ww[q] = (unsigned)pk; }
        w.x = ww[0]; w.y = ww[1]; w.z = ww[2]; w.w = ww[3];
        unsigned char* dst = ws + (tb ? WS_V8 : WS_U8) + (((size_t)l * 8 + (lane >> 3)) * NEXP + e) * 128 + 16 * (lane & 7);
        *(u32x4*)dst = w;
        if (lane == 0) ((float*)(ws + (tb ? WS_VSC : WS_USC)))[l * NEXP + e] = am * (1.0f / 256.0f);
    }
    for (int i = c * 512 + tid; i < 32 * 132; i += G * 512) { const int hh = i / 132, ds = i % 132; const int dil = hh < 16 ? 1 : (hh < 24 ? 4 : 16); const int d = ds * dil;
        int bucket = d;
        if (d >= 16) { bucket = 16 + (int)(log((double)d / 16.0) / log(128.0) * 16.0); if (bucket > 31) bucket = 31; }
        ((float*)(ws + WS_LUT))[i] = p.rel_bias[bucket * 32 + hh]; }
    rmsnorm_phase<true>(p.x, p.norm_mix, ws + WS_H, G, c);
}

struct AttnUnit { int qcol, kcol, vcol, dil, maxd, lutrow, batch, r, blk, head; float sink; float* lse; };
__device__ __forceinline__ void attn_decode(const Params& p, int layer, bool groupB, int u, AttnUnit& a) {
    if (!groupB) { a.head = u & 7; const int rest = u >> 3; a.batch = rest >> 4; a.blk = rest & 15; a.r = 0; a.dil = 1; a.maxd = 127;
        a.qcol = C_QA + 64 * a.head; a.kcol = C_KA + 64 * (a.head >> 2); a.vcol = C_VA + 64 * (a.head >> 2); a.lutrow = a.head; a.sink = p.sinks[layer * 8 + a.head]; a.lse = nullptr; }
    else { const int g = u >> 10, uu = u & 1023; a.head = uu & 7; const int rest = uu >> 3; a.batch = rest >> 4; const int sb = rest & 15; a.dil = 1 << (2 * g); const int nblk = 16 >> (2 * g);
        a.r = sb / nblk; a.blk = sb % nblk; a.maxd = 128; const int base = C_B0 + 1536 * g;
        a.qcol = base + 64 * a.head; a.kcol = base + 512 + 64 * a.head; a.vcol = base + 1024 + 64 * a.head; a.lutrow = 8 + 8 * g + a.head; a.sink = -3.0e38f; a.lse = (float*)(p.ws + WS_LSE) + (size_t)g * T_TOK * 8; }
}
__device__ __forceinline__ void attn_issue(const bf16_t* P, const AttnUnit& a, int tid, int w, int j, int g4, uint4 (&kreg)[4], uint4 (&vreg)[4], uint4 (&qreg)[2]) {
#pragma unroll
    for (int q = 0; q < 4; ++q) { const int piece = tid + 512 * q, row = piece >> 3, seg = piece & 7; const int sub = 128 * (a.blk - 1) + row;
        if (sub >= 0) { const size_t grow = (size_t)a.batch * SEQ + (size_t)sub * a.dil + a.r; const bf16_t* b = P + grow * NP + 8 * seg;
            kreg[q] = *(const uint4*)(b + a.kcol); vreg[q] = *(const uint4*)(b + a.vcol); }
        else { kreg[q] = make_uint4(0u, 0u, 0u, 0u); vreg[q] = make_uint4(0u, 0u, 0u, 0u); } }
    const size_t qrow = (size_t)a.batch * SEQ + (size_t)(128 * a.blk + 16 * w + j) * a.dil + a.r; const bf16_t* qp = P + qrow * NP + a.qcol + 8 * g4;
    qreg[0] = *(const uint4*)qp; qreg[1] = *(const uint4*)(qp + 32);
}
__device__ __forceinline__ bf16x8 as_bf16x8(uint4 v) { union { uint4 u; bf16x8 b; } x; x.u = v; return x.b; }
__device__ __forceinline__ bf16x8 mk_bf16x8(unsigned a, unsigned b, unsigned c, unsigned d) { union { unsigned u[4]; bf16x8 v; } x; x.u[0] = a; x.u[1] = b; x.u[2] = c; x.u[3] = d; return x.v; }

__device__ __forceinline__ void attn_phase(const Params& p, LAS unsigned char* L, int layer, bool groupB, int G, int c) {
    const int tid = opaque_tid(), lane = tid & 63, w = __builtin_amdgcn_readfirstlane(tid >> 6), j = lane & 15, g4 = lane >> 4;
    bf16_t* P = (bf16_t*)(p.ws + WS_P);
    const float* lutg = (const float*)(p.ws + WS_LUT);
    LAS unsigned char* Ks = L; LAS unsigned char* Vt = L + 36864; LAS float* lutL = (LAS float*)(L + 36864 + 33792);
    const int nunits = groupB ? 3072 : 1024;
    int u = c; if (u >= nunits) return;
    uint4 kreg[4], vreg[4], qreg[2]; AttnUnit cu, nu;
    attn_decode(p, layer, groupB, u, cu); attn_issue(P, cu, tid, w, j, g4, kreg, vreg, qreg);
    for (;;) {
#pragma unroll
        for (int q = 0; q < 4; ++q) { const int piece = tid + 512 * q, row = piece >> 3, seg = piece & 7;
            *(LAS u32x4*)(Ks + row * 144 + seg * 16) = (u32x4){kreg[q].x, kreg[q].y, kreg[q].z, kreg[q].w};
            const unsigned vw[4] = {vreg[q].x, vreg[q].y, vreg[q].z, vreg[q].w};
#pragma unroll
            for (int e = 0; e < 8; ++e) *(LAS unsigned short*)(Vt + (8 * seg + e) * 528 + row * 2) = (unsigned short)((e & 1) ? (vw[e >> 1] >> 16) : (vw[e >> 1] & 0xffffu)); }
        if (tid < 132) lutL[tid] = lutg[cu.lutrow * 132 + tid];
        const bf16x8 qf0 = as_bf16x8(qreg[0]), qf1 = as_bf16x8(qreg[1]);
        WG_SYNC();
        const int un = u + G; const bool has_next = un < nunits;
        if (has_next) { attn_decode(p, layer, groupB, un, nu); attn_issue(P, nu, tid, w, j, g4, kreg, vreg, qreg); }
        f32x4 sacc[9];
#pragma unroll
        for (int kt = 0; kt < 9; ++kt) { sacc[kt] = (f32x4){0.f, 0.f, 0.f, 0.f};
            const LAS unsigned char* kb = Ks + (16 * (w + kt) + j) * 144 + 16 * g4;
            sacc[kt] = __builtin_amdgcn_mfma_f32_16x16x32_bf16(*(const LAS bf16x8*)kb, qf0, sacc[kt], 0, 0, 0);
            sacc[kt] = __builtin_amdgcn_mfma_f32_16x16x32_bf16(*(const LAS bf16x8*)(kb + 64), qf1, sacc[kt], 0, 0, 0); }
        float mx = -3.0e38f;
#pragma unroll
        for (int kt = 0; kt < 9; ++kt)
#pragma unroll
            for (int e = 0; e < 4; ++e) { const int dist = 128 + j - 16 * kt - 4 * g4 - e; const int kj = 16 * (w + kt) + 4 * g4 + e;
                const bool valid = (dist >= 0) && (dist <= cu.maxd) && (cu.blk > 0 || kj >= 128);
                const int di = dist < 0 ? 0 : (dist > 131 ? 131 : dist);
                const float s = valid ? sacc[kt][e] * 0.125f + lutL[di] : -1.0e30f;
                sacc[kt][e] = s; mx = fmaxf(mx, s); }
        mx = fmaxf(mx, __shfl_xor(mx, 16)); mx = fmaxf(mx, __shfl_xor(mx, 32)); mx = fmaxf(mx, cu.sink);
        float sum = 0.f;
#pragma unroll
        for (int kt = 0; kt < 9; ++kt)
#pragma unroll
            for (int e = 0; e < 4; ++e) { const float pv = fexp(sacc[kt][e] - mx); sacc[kt][e] = pv; sum += pv; }
        sum += __shfl_xor(sum, 16); sum += __shfl_xor(sum, 32);
        const float denom = sum + fexp(cu.sink - mx);
        bf16x8 pb[5];
#pragma unroll
        for (int cc = 0; cc < 5; ++cc) { const unsigned a0 = cvt_pk_bf16(sacc[2 * cc][0], sacc[2 * cc][1]), a1 = cvt_pk_bf16(sacc[2 * cc][2], sacc[2 * cc][3]);
            unsigned b0 = 0u, b1 = 0u; if (cc < 4) { b0 = cvt_pk_bf16(sacc[2 * cc + 1][0], sacc[2 * cc + 1][1]); b1 = cvt_pk_bf16(sacc[2 * cc + 1][2], sacc[2 * cc + 1][3]); }
            pb[cc] = mk_bf16x8(a0, a1, b0, b1); }
        f32x4 oacc[4];
#pragma unroll
        for (int dt = 0; dt < 4; ++dt) { oacc[dt] = (f32x4){0.f, 0.f, 0.f, 0.f};
#pragma unroll
            for (int cc = 0; cc < 5; ++cc) { const LAS unsigned char* vb = Vt + (16 * dt + j) * 528 + (16 * (w + 2 * cc) + 4 * g4) * 2;
                const u32x2 lo = *(const LAS u32x2*)vb; u32x2 hi = (u32x2){0u, 0u}; if (cc < 4) hi = *(const LAS u32x2*)(vb + 32);
                oacc[dt] = __builtin_amdgcn_mfma_f32_16x16x32_bf16(mk_bf16x8(lo.x, lo.y, hi.x, hi.y), pb[cc], oacc[dt], 0, 0, 0); } }
        const float inv = __builtin_amdgcn_rcpf(denom);
        const size_t qrow = (size_t)cu.batch * SEQ + (size_t)(128 * cu.blk + 16 * w + j) * cu.dil + cu.r;
        bf16_t* op = P + qrow * NP + cu.qcol + 4 * g4;
#pragma unroll
        for (int dt = 0; dt < 4; ++dt) { u32x2 o; o.x = cvt_pk_bf16(oacc[dt][0] * inv, oacc[dt][1] * inv); o.y = cvt_pk_bf16(oacc[dt][2] * inv, oacc[dt][3] * inv); *(u32x2*)(op + 16 * dt) = o; }
        if (cu.lse != nullptr && g4 == 0) cu.lse[qrow * 8 + cu.head] = mx + flog(denom);
        WG_SYNC();
        if (!has_next) break;
        cu = nu; u = un;
    }
}
__device__ __forceinline__ void combine_phase(const Params& p, int G, int c) {
    bf16_t* P = (bf16_t*)(p.ws + WS_P); const float* LSE = (const float*)(p.ws + WS_LSE);
    const int tid = opaque_tid();
    for (int i = c * 512 + tid; i < T_TOK * 64; i += G * 512) { const int seg = i & 7, h = (i >> 3) & 7, t = i >> 6;
        const float l0 = LSE[(size_t)t * 8 + h], l1 = LSE[(size_t)T_TOK * 8 + (size_t)t * 8 + h], l2 = LSE[(size_t)2 * T_TOK * 8 + (size_t)t * 8 + h];
        const float m = fmaxf(l0, fmaxf(l1, l2)); float w0 = fexp(l0 - m), w1 = fexp(l1 - m), w2 = fexp(l2 - m); const float inv = 1.0f / (w0 + w1 + w2); w0 *= inv; w1 *= inv; w2 *= inv;
        bf16_t* b = P + (size_t)t * NP + C_B0 + 64 * h + 8 * seg;
        const u32x4 a0 = *(const u32x4*)b, a1 = *(const u32x4*)(b + 1536), a2 = *(const u32x4*)(b + 3072);
        u32x4 o;
        o.x = cvt_pk_bf16(w0 * bflo(a0.x) + w1 * bflo(a1.x) + w2 * bflo(a2.x), w0 * bfhi(a0.x) + w1 * bfhi(a1.x) + w2 * bfhi(a2.x));
        o.y = cvt_pk_bf16(w0 * bflo(a0.y) + w1 * bflo(a1.y) + w2 * bflo(a2.y), w0 * bfhi(a0.y) + w1 * bfhi(a1.y) + w2 * bfhi(a2.y));
        o.z = cvt_pk_bf16(w0 * bflo(a0.z) + w1 * bflo(a1.z) + w2 * bflo(a2.z), w0 * bfhi(a0.z) + w1 * bfhi(a1.z) + w2 * bfhi(a2.z));
        o.w = cvt_pk_bf16(w0 * bflo(a0.w) + w1 * bflo(a1.w) + w2 * bflo(a2.w), w0 * bfhi(a0.w) + w1 * bfhi(a1.w) + w2 * bfhi(a2.w));
        *(u32x4*)b = o; }
}

__device__ __forceinline__ void gla_cum(const bf16_t* P, size_t trow0, int h, int c, int s, LAS float* tot, float (&cum)[8], float& last) {
    float run = 0.f;
#pragma unroll
    for (int jr = 0; jr < 8; ++jr) { run += bf2f(P[(trow0 + 8 * s + jr) * NP + C_Z + 64 * h + c]); cum[jr] = run; }
    tot[s * 64 + c] = run;
    WG_SYNC();
    float off = 0.f, all = 0.f;
#pragma unroll
    for (int s2 = 0; s2 < 8; ++s2) { const float v = tot[s2 * 64 + c]; all += v; off += (s2 < s) ? v : 0.f; }
#pragma unroll
    for (int jr = 0; jr < 8; ++jr) cum[jr] += off;
    last = all;
}
__device__ __forceinline__ void gla_stage_vt(const bf16_t* P, size_t trow0, int h, LAS unsigned char* Vt, int tid) {
#pragma unroll
    for (int q = 0; q < 2; ++q) { const int piece = tid + 512 * q, t = piece >> 4, seg = piece & 15;
        const uint4 vv = *(const uint4*)(P + (trow0 + t) * NP + C_VC + 128 * h + 8 * seg); const unsigned vw[4] = {vv.x, vv.y, vv.z, vv.w};
#pragma unroll
        for (int e = 0; e < 8; ++e) *(LAS unsigned short*)(Vt + (8 * seg + e) * 144 + 2 * t) = (unsigned short)((e & 1) ? (vw[e >> 1] >> 16) : (vw[e >> 1] & 0xffffu)); }
}
__device__ __forceinline__ void gla_a_phase(const Params& p, LAS unsigned char* L, int G, int c) {
    const int tid = opaque_tid(), lane = tid & 63, w = __builtin_amdgcn_readfirstlane(tid >> 6), j = lane & 15, g4 = lane >> 4, cc = tid & 63, s = tid >> 6;
    const bf16_t* P = (const bf16_t*)(p.ws + WS_P); float* KV = (float*)(p.ws + WS_H); float* DEC = (float*)(p.ws + WS_DECAY);
    LAS unsigned char* KeT = L; LAS unsigned char* Vt = L + 9216; LAS float* tot = (LAS float*)(L + 27648);
    for (int u = c; u < 1024; u += G) { const int h = u & 3, n = (u >> 2) & 31, b = u >> 7; const size_t trow0 = (size_t)b * SEQ + 64 * n; const int base = (b * 32 + n) * 4 + h;
        float cum[8], last; gla_cum(P, trow0, h, cc, s, tot, cum, last);
        float ke[8];
#pragma unroll
        for (int jr = 0; jr < 8; ++jr) ke[jr] = bf2f(P[(trow0 + 8 * s + jr) * NP + C_KC + 64 * h + cc]) * fexp(last - cum[jr]);
        u32x4 kw; kw.x = cvt_pk_bf16(ke[0], ke[1]); kw.y = cvt_pk_bf16(ke[2], ke[3]); kw.z = cvt_pk_bf16(ke[4], ke[5]); kw.w = cvt_pk_bf16(ke[6], ke[7]);
        *(LAS u32x4*)(KeT + cc * 144 + 16 * s) = kw;
        gla_stage_vt(P, trow0, h, Vt, tid);
        if (s == 0) DEC[base * 64 + cc] = fexp(last);
        WG_SYNC();
        f32x4 acc[4];
#pragma unroll
        for (int ct = 0; ct < 4; ++ct) acc[ct] = (f32x4){0.f, 0.f, 0.f, 0.f};
#pragma unroll
        for (int k2 = 0; k2 < 2; ++k2) { const bf16x8 af = *(const LAS bf16x8*)(Vt + (16 * w + j) * 144 + (8 * g4 + 32 * k2) * 2);
#pragma unroll
            for (int ct = 0; ct < 4; ++ct) acc[ct] = __builtin_amdgcn_mfma_f32_16x16x32_bf16(af, *(const LAS bf16x8*)(KeT + (16 * ct + j) * 144 + (8 * g4 + 32 * k2) * 2), acc[ct], 0, 0, 0); }
#pragma unroll
        for (int ct = 0; ct < 4; ++ct)
#pragma unroll
            for (int e = 0; e < 4; ++e) KV[((size_t)base * 128 + 16 * w + 4 * g4 + e) * 64 + 16 * ct + j] = acc[ct][e];
        WG_SYNC();
    }
}
__device__ __forceinline__ void gla_scan_phase(const Params& p, int G, int c) {
    const float* KV = (const float*)(p.ws + WS_H); const float* DEC = (const float*)(p.ws + WS_DECAY); bf16_t* SP = (bf16_t*)(p.ws + WS_SPREV);
    const int tid = opaque_tid();
    for (int eid = c * 512 + tid; eid < 262144; eid += G * 512) { const int cc = eid & 63, v = (eid >> 6) & 127, h = (eid >> 13) & 3, b = eid >> 15;
        float state = 0.f;
#pragma unroll 8
        for (int n = 0; n < 32; ++n) { const int base = (b * 32 + n) * 4 + h; const size_t idx = ((size_t)base * 128 + v) * 64 + cc;
            SP[idx] = (bf16_t)(cvt_pk_bf16(state, 0.f) & 0xffffu); state = state * DEC[base * 64 + cc] + KV[idx]; } }
}
__device__ __forceinline__ void gla_c_phase(const Params& p, LAS unsigned char* L, int layer, int G, int c) {
    const int tid = opaque_tid(), lane = tid & 63, w = __builtin_amdgcn_readfirstlane(tid >> 6), j = lane & 15, g4 = lane >> 4, cc = tid & 63, s = tid >> 6;
    bf16_t* P = (bf16_t*)(p.ws + WS_P); const bf16_t* SP = (const bf16_t*)(p.ws + WS_SPREV);
    LAS unsigned char* QD = L; LAS unsigned char* KI = L + 9216; LAS unsigned char* Vt = L + 18432; LAS float* tot = (LAS float*)(L + 36864); LAS float* ssb = (LAS float*)(L + 38912);
    const int tt = w & 3, vh = w >> 2;
    for (int u = c; u < 1024; u += G) { const int h = u & 3, n = (u >> 2) & 31, b = u >> 7; const size_t trow0 = (size_t)b * SEQ + 64 * n; const int base = (b * 32 + n) * 4 + h;
        float cum[8], last; gla_cum(P, trow0, h, cc, s, tot, cum, last);
#pragma unroll
        for (int jr = 0; jr < 8; ++jr) { const size_t ro = (trow0 + 8 * s + jr) * NP + 64 * h + cc;
            const float qd = bf2f(P[ro + C_QC]) * 0.125f * fexp(cum[jr]), ki = bf2f(P[ro + C_KC]) * fexp(-cum[jr]);
            *(LAS unsigned short*)(QD + (8 * s + jr) * 144 + 2 * cc) = (unsigned short)(cvt_pk_bf16(qd, 0.f) & 0xffffu);
            *(LAS unsigned short*)(KI + (8 * s + jr) * 144 + 2 * cc) = (unsigned short)(cvt_pk_bf16(ki, 0.f) & 0xffffu); }
        gla_stage_vt(P, trow0, h, Vt, tid);
        WG_SYNC();
        bf16x8 qdf[2];
#pragma unroll
        for (int k2 = 0; k2 < 2; ++k2) qdf[k2] = *(const LAS bf16x8*)(QD + (16 * tt + j) * 144 + (8 * g4 + 32 * k2) * 2);
        f32x4 sa[4];
#pragma unroll
        for (int st = 0; st < 4; ++st) { sa[st] = (f32x4){0.f, 0.f, 0.f, 0.f};
            if (st <= tt) {
#pragma unroll
                for (int k2 = 0; k2 < 2; ++k2) sa[st] = __builtin_amdgcn_mfma_f32_16x16x32_bf16(*(const LAS bf16x8*)(KI + (16 * st + j) * 144 + (8 * g4 + 32 * k2) * 2), qdf[k2], sa[st], 0, 0, 0);
                if (st == tt) {
#pragma unroll
                    for (int e = 0; e < 4; ++e) if (4 * g4 + e > j) sa[st][e] = 0.f; } } }
        bf16x8 pb[2];
#pragma unroll
        for (int c2 = 0; c2 < 2; ++c2) pb[c2] = mk_bf16x8(cvt_pk_bf16(sa[2 * c2][0], sa[2 * c2][1]), cvt_pk_bf16(sa[2 * c2][2], sa[2 * c2][3]), cvt_pk_bf16(sa[2 * c2 + 1][0], sa[2 * c2 + 1][1]), cvt_pk_bf16(sa[2 * c2 + 1][2], sa[2 * c2 + 1][3]));
        f32x4 oacc[4]; float ss = 0.f;
#pragma unroll
        for (int vt = 0; vt < 4; ++vt) { const int V = 4 * vh + vt; oacc[vt] = (f32x4){0.f, 0.f, 0.f, 0.f};
#pragma unroll
            for (int c2 = 0; c2 < 2; ++c2) { const LAS unsigned char* vb = Vt + (16 * V + j) * 144 + (32 * c2 + 4 * g4) * 2; const u32x2 lo = *(const LAS u32x2*)vb, hi = *(const LAS u32x2*)(vb + 32);
                oacc[vt] = __builtin_amdgcn_mfma_f32_16x16x32_bf16(mk_bf16x8(lo.x, lo.y, hi.x, hi.y), pb[c2], oacc[vt], 0, 0, 0); }
#pragma unroll
            for (int k2 = 0; k2 < 2; ++k2) { const bf16x8 spf = *(const bf16x8*)(SP + ((size_t)base * 128 + 16 * V + j) * 64 + 8 * g4 + 32 * k2);
                oacc[vt] = __builtin_amdgcn_mfma_f32_16x16x32_bf16(spf, qdf[k2], oacc[vt], 0, 0, 0); }
            ss += oacc[vt][0] * oacc[vt][0] + oacc[vt][1] * oacc[vt][1] + oacc[vt][2] * oacc[vt][2] + oacc[vt][3] * oacc[vt][3]; }
        ss += __shfl_xor(ss, 16); ss += __shfl_xor(ss, 32);
        if (g4 == 0) ssb[vh * 64 + 16 * tt + j] = ss;
        WG_SYNC();
        const float rstd = __builtin_amdgcn_rsqf((ssb[16 * tt + j] + ssb[64 + 16 * tt + j]) * (1.0f / 128.0f) + 1e-6f);
        bf16_t* orow = P + (trow0 + 16 * tt + j) * NP + 128 * h;
#pragma unroll
        for (int vt = 0; vt < 4; ++vt) { const int v0 = 16 * (4 * vh + vt) + 4 * g4; const u32x2 rr = *(const u32x2*)(orow + C_RC + v0); const f32x4 hn = *(const f32x4*)(p.head_norm + layer * 128 + v0);
            const float r0 = bflo(rr.x), r1 = bfhi(rr.x), r2 = bflo(rr.y), r3 = bfhi(rr.y);
            u32x2 o; o.x = cvt_pk_bf16(oacc[vt][0] * rstd * hn[0] * r0 * fsigmoid(r0), oacc[vt][1] * rstd * hn[1] * r1 * fsigmoid(r1));
            o.y = cvt_pk_bf16(oacc[vt][2] * rstd * hn[2] * r2 * fsigmoid(r2), oacc[vt][3] * rstd * hn[3] * r3 * fsigmoid(r3));
            *(u32x2*)(orow + C_VC + v0) = o; }
        WG_SYNC();
    }
}

__device__ __forceinline__ int sort_key(float f) { const int u = __float_as_int(f); return u ^ ((u >> 31) & 0x7fffffff); }
__device__ __forceinline__ int med3i(int a, int b, int c) { return max(min(a, b), min(max(a, b), c)); }
__device__ __forceinline__ void topk_insert(int (&v)[16], int x) {
#pragma unroll
    for (int i = 15; i >= 1; --i) v[i] = med3i(v[i - 1], x, v[i]);
    v[0] = max(v[0], x);
}
__device__ __forceinline__ void peer_topk_phase(const Params& p, LAS unsigned char* L, int layer, int G, int c) {
    const int tid = opaque_tid(), lane = tid & 63, w = __builtin_amdgcn_readfirstlane(tid >> 6), j = lane & 15, g4 = lane >> 4;
    const bf16_t* QY = (const bf16_t*)(p.ws + WS_QY); const bf16_t* KEYS = (const bf16_t*)(p.ws + WS_KEYS); int* IDX = (int*)(p.ws + WS_IDX); float* GATE = (float*)(p.ws + WS_GATE);
    LAS float* SC = (LAS float*)L; LAS float* TS = (LAS float*)(L + 66048); LAS int* TI = (LAS int*)(L + 74240);
    const int pp = w >> 2, tg = w & 3;
    for (int u = c; u < 2048; u += G) { const int h = u & 7, tb = u >> 3;
        bf16x8 af[4];
#pragma unroll
        for (int kc = 0; kc < 4; ++kc) af[kc] = *(const bf16x8*)(QY + (size_t)(64 * tb + 16 * tg + j) * 2048 + h * 256 + pp * 128 + 8 * g4 + 32 * kc);
#pragma unroll
        for (int nt = 0; nt < 8; ++nt) { f32x4 acc = (f32x4){0.f, 0.f, 0.f, 0.f};
#pragma unroll
            for (int kc = 0; kc < 4; ++kc) acc = __builtin_amdgcn_mfma_f32_16x16x32_bf16(af[kc], *(const bf16x8*)(KEYS + ((size_t)((layer * 8 + h) * 2 + pp) * 128 + 16 * nt + j) * 128 + 8 * g4 + 32 * kc), acc, 0, 0, 0);
#pragma unroll
            for (int e = 0; e < 4; ++e) SC[((16 * tg + 4 * g4 + e) * 2 + pp) * 129 + 16 * nt + j] = acc[e]; }
        WG_SYNC();
        if (tid < 128) { const LAS float* base = SC + tid * 129;
            int v[16];
#pragma unroll
            for (int i = 0; i < 16; ++i) v[i] = (int)0x80000000;
#pragma unroll 8
            for (int n = 0; n < 128; ++n) topk_insert(v, (sort_key(base[n]) & ~127) | (127 - n));
#pragma unroll
            for (int a = 0; a < 16; ++a) { const int ni = 127 - (v[a] & 127); TS[tid * 16 + a] = base[ni]; TI[tid * 16 + a] = ni; } }
        WG_SYNC();
        if (tid < 64) { float s1[16], s2[16];
#pragma unroll
            for (int a = 0; a < 16; ++a) { s1[a] = TS[(tid * 2) * 16 + a]; s2[a] = TS[(tid * 2 + 1) * 16 + a]; }
            int v[16];
#pragma unroll
            for (int i = 0; i < 16; ++i) v[i] = (int)0x80000000;
#pragma unroll
            for (int a = 0; a < 16; ++a)
#pragma unroll
                for (int b = 0; b < 16; ++b) if ((a + 1) * (b + 1) <= 16) topk_insert(v, (sort_key(s1[a] + s2[b]) & ~255) | (255 - (16 * a + b)));
            float ts[16]; int ex[16]; float mx = -3.0e38f;
#pragma unroll
            for (int k = 0; k < 16; ++k) { const int pos = 255 - (v[k] & 255), a = pos >> 4, b = pos & 15;
                ts[k] = TS[(tid * 2) * 16 + a] + TS[(tid * 2 + 1) * 16 + b]; ex[k] = TI[(tid * 2) * 16 + a] * 128 + TI[(tid * 2 + 1) * 16 + b]; mx = fmaxf(mx, ts[k]); }
            float sum = 0.f;
#pragma unroll
            for (int k = 0; k < 16; ++k) { ts[k] = fexp(ts[k] - mx); sum += ts[k]; }
            const float inv = 1.0f / sum; const size_t o = ((size_t)(64 * tb + tid) * 8 + h) * 16;
#pragma unroll
            for (int k = 0; k < 16; k += 4) { *(int4*)(IDX + o + k) = make_int4(ex[k], ex[k + 1], ex[k + 2], ex[k + 3]); *(f32x4*)(GATE + o + k) = (f32x4){ts[k] * inv, ts[k + 1] * inv, ts[k + 2] * inv, ts[k + 3] * inv}; } }
        WG_SYNC();
    }
}

__device__ __forceinline__ void fp8x16_to_f32(const uint4 d, float (&f)[16]) {
    const unsigned w[4] = {d.x, d.y, d.z, d.w};
#pragma unroll
    for (int q = 0; q < 4; ++q) { const f32x2 a = __builtin_amdgcn_cvt_pk_f32_fp8((int)w[q], false), b = __builtin_amdgcn_cvt_pk_f32_fp8((int)w[q], true);
        f[4 * q] = a.x; f[4 * q + 1] = a.y; f[4 * q + 2] = b.x; f[4 * q + 3] = b.y; }
}
__device__ __forceinline__ void peer_u_phase(const Params& p, int layer, int G, int c) {
    const int tid = opaque_tid(), lane = tid & 63, w = tid >> 6, sub = lane & 7, grp = lane >> 3;
    const bf16_t* XN = (const bf16_t*)(p.ws + WS_H); const int* IDX = (const int*)(p.ws + WS_IDX); float* HIDP = (float*)(p.ws + WS_HIDP);
    for (int item = c; item < 8 * 2048; item += G) { const int js = item & 7, t = (item >> 3) * 8 + w;
        const unsigned char* U8 = p.ws + WS_U8 + ((size_t)layer * 8 + js) * NEXP * 128 + 16 * sub;
        const uint4 x0 = *(const uint4*)(XN + (size_t)t * DM + 128 * js + 16 * sub), x1 = *(const uint4*)(XN + (size_t)t * DM + 128 * js + 16 * sub + 8);
        float xs[16];
        xs[0] = bflo(x0.x); xs[1] = bfhi(x0.x); xs[2] = bflo(x0.y); xs[3] = bfhi(x0.y); xs[4] = bflo(x0.z); xs[5] = bfhi(x0.z); xs[6] = bflo(x0.w); xs[7] = bfhi(x0.w);
        xs[8] = bflo(x1.x); xs[9] = bfhi(x1.x); xs[10] = bflo(x1.y); xs[11] = bfhi(x1.y); xs[12] = bflo(x1.z); xs[13] = bfhi(x1.z); xs[14] = bflo(x1.w); xs[15] = bfhi(x1.w);
        uint4 d[16];
#pragma unroll
        for (int i = 0; i < 16; ++i) { const int e = IDX[(size_t)t * 128 + 8 * i + grp]; d[i] = *(const uint4*)(U8 + (size_t)e * 128); }
        float o0 = 0.f, o1 = 0.f;
#pragma unroll
        for (int i = 0; i < 16; ++i) { float f[16]; fp8x16_to_f32(d[i], f); float a = 0.f;
#pragma unroll
            for (int q = 0; q < 16; ++q) a += f[q] * xs[q];
            a += __shfl_xor(a, 1); a += __shfl_xor(a, 2); a += __shfl_xor(a, 4);
            if (i < 8) o0 = (sub == i) ? a : o0; else o1 = (sub == i - 8) ? a : o1; }
        HIDP[((size_t)t * 128 + 8 * sub + grp) * 8 + js] = o0;
        HIDP[((size_t)t * 128 + 8 * (sub + 8) + grp) * 8 + js] = o1;
    }
}
__device__ __forceinline__ void peer_v_phase(const Params& p, LAS unsigned char* L, int layer, const float* xsrc, int G, int c) {
    const int tid = opaque_tid(), lane = tid & 63, w = tid >> 6, sub = lane & 7, grp = lane >> 3;
    const int* IDX = (const int*)(p.ws + WS_IDX); const float* GATE = (const float*)(p.ws + WS_GATE); const float* HIDP = (const float*)(p.ws + WS_HIDP);
    const float* USC = (const float*)(p.ws + WS_USC) + layer * NEXP; const float* VSC = (const float*)(p.ws + WS_VSC) + layer * NEXP;
    LAS u32x2* EW = (LAS u32x2*)(L + w * 1024);
    for (int item = c; item < 8 * 2048; item += G) { const int js = item & 7, t = (item >> 3) * 8 + w;
        const unsigned char* V8 = p.ws + WS_V8 + ((size_t)layer * 8 + js) * NEXP * 128 + 16 * sub;
        {
            const float* hp = HIDP + ((size_t)t * 128 + 2 * lane) * 8;
            const f32x4 h0 = *(const f32x4*)hp, h1 = *(const f32x4*)(hp + 4), h2 = *(const f32x4*)(hp + 8), h3 = *(const f32x4*)(hp + 12);
            const int2 ee = *(const int2*)(IDX + (size_t)t * 128 + 2 * lane); const f32x2 gg = *(const f32x2*)(GATE + (size_t)t * 128 + 2 * lane);
            const float hid0 = ((h0[0] + h0[1]) + (h0[2] + h0[3]) + (h1[0] + h1[1]) + (h1[2] + h1[3])) * USC[ee.x];
            const float hid1 = ((h2[0] + h2[1]) + (h2[2] + h2[3]) + (h3[0] + h3[1]) + (h3[2] + h3[3])) * USC[ee.y];
            const float w0 = gg.x * fgelu_tanh(hid0) * VSC[ee.x], w1 = gg.y * fgelu_tanh(hid1) * VSC[ee.y];
            EW[2 * lane] = (u32x2){(unsigned)ee.x, __float_as_uint(w0)}; EW[2 * lane + 1] = (u32x2){(unsigned)ee.y, __float_as_uint(w1)};
        }
        __builtin_amdgcn_fence(__ATOMIC_RELEASE, "wavefront"); __builtin_amdgcn_wave_barrier(); __builtin_amdgcn_fence(__ATOMIC_ACQUIRE, "wavefront");
        float acc[16];
#pragma unroll
        for (int q = 0; q < 16; ++q) acc[q] = 0.f;
        uint4 d[16]; float wv[16];
#pragma unroll
        for (int i = 0; i < 16; ++i) { const u32x2 ew = EW[8 * i + grp]; wv[i] = __uint_as_float(ew.y); d[i] = *(const uint4*)(V8 + (size_t)ew.x * 128); }
#pragma unroll
        for (int i = 0; i < 16; ++i) { float f[16]; fp8x16_to_f32(d[i], f);
#pragma unroll
            for (int q = 0; q < 16; ++q) acc[q] += wv[i] * f[q]; }
#pragma unroll
        for (int q = 0; q < 16; ++q) { acc[q] += __shfl_xor(acc[q], 8); acc[q] += __shfl_xor(acc[q], 16); acc[q] += __shfl_xor(acc[q], 32); }
        if (grp == 0) { const size_t o = (size_t)t * DM + 128 * js + 16 * sub;
#pragma unroll
            for (int q = 0; q < 4; ++q) { const f32x4 xv = *(const f32x4*)(xsrc + o + 4 * q); *(f32x4*)(p.out + o + 4 * q) = xv + (f32x4){acc[4 * q], acc[4 * q + 1], acc[4 * q + 2], acc[4 * q + 3]}; } }
        __builtin_amdgcn_wave_barrier();
    }
}

#ifndef MK_PER_PHASE
#define MK_PER_PHASE 1
#endif
constexpr int N_PHASES = 1 + 12 * NLAYER;

__global__ void __launch_bounds__(512, 2) mega_fwd(Params p) {
    extern __shared__ __attribute__((aligned(16))) unsigned char lds_raw[];
    LAS unsigned char* L = (LAS unsigned char*)lds_raw;
    const int G = (int)gridDim.x, c = (int)blockIdx.x;
    volatile LAS unsigned* st = (volatile LAS unsigned*)(L + LDS_MISC);
    if (threadIdx.x < 4) st[threadIdx.x] = 0u;
    __syncthreads();
    const int lo = p.ph_lo, hi = p.ph_hi;
    XcdBarrier bar; bar.bar = (unsigned*)(p.ws + WS_CTL); bar.x = 0; bar.st = st;
    if (hi - lo > 1) bar = xcd_barrier_post((unsigned*)(p.ws + WS_CTL), st);
#ifndef MK_ONLY
#define MK_ONLY -1
#endif
#define IN(k) (lo <= (k) && (k) < hi)
#define KIND(q) (MK_ONLY < 0 || MK_ONLY == (q))
#define SEAM(k) do { if (IN(k) && IN((k) + 1)) xcd_barrier(bar); } while (0)
    unsigned char* ws = p.ws;
    bf16_t* P = (bf16_t*)(ws + WS_P); bf16_t* H = (bf16_t*)(ws + WS_H);

    if (IN(0) && KIND(0)) prologue_phase(p, L, G, c);
    SEAM(0);
    for (int l = 0; l < NLAYER; ++l) {
        const int pb = 1 + 12 * l;
        if (IN(pb + 0) && KIND(1)) { Gemm g{H, (const bf16_t*)(ws + WS_WIN) + (size_t)l * NP * 1024, T_TOK, NP, 1024, 1024, 1024}; StaticOrder S; S.init(T_TOK, NP, G, c);
            pg8::EpiIn E{P, p.alpha_b + l * 256}; pg8::gemm_phase<pg8::EpiIn, StaticOrder>(L, g, S, E, nullptr); }
        SEAM(pb + 0);
        if (IN(pb + 1) && KIND(2)) { attn_phase(p, L, l, false, G, c); gla_a_phase(p, L, G, c); }
        SEAM(pb + 1);
        if (IN(pb + 2) && KIND(3)) { gla_scan_phase(p, G, c); attn_phase(p, L, l, true, G, c); }
        SEAM(pb + 2);
        if (IN(pb + 3) && KIND(4)) { gla_c_phase(p, L, l, G, c); combine_phase(p, G, c); }
        SEAM(pb + 3);
        if (IN(pb + 4) && KIND(5)) { Gemm g{P, (const bf16_t*)(ws + WS_WBR) + (size_t)l * 3 * 1024 * 512, T_TOK, 1024, 512, NP, 512}; MergeOrder S; S.init(T_TOK, 1024, G, c);
            pg8::EpiMerge E{P, H}; pg8::gemm_phase<pg8::EpiMerge, MergeOrder>(L, g, S, E, nullptr); }
        SEAM(pb + 4);
        if (IN(pb + 5) && KIND(6)) { Gemm g{H, (const bf16_t*)(ws + WS_WOUT) + (size_t)l * 1024 * 1024, T_TOK, 1024, 1024, 1024, 1024}; StaticOrder S; S.init(T_TOK, 1024, G, c);
            pg8::EpiResid E{l == 0 ? p.x : (const float*)p.out, p.out}; pg8::gemm_phase<pg8::EpiResid, StaticOrder>(L, g, S, E, nullptr); }
        SEAM(pb + 5);
        if (IN(pb + 6) && KIND(7)) rmsnorm_phase<true>(p.out, p.norm_ffn + l * 1024, H, G, c);
        SEAM(pb + 6);
        if (IN(pb + 7) && KIND(8)) { Gemm g{H, (const bf16_t*)(ws + WS_WQ) + (size_t)l * 2048 * 1024, T_TOK, 2048, 1024, 1024, 1024}; StaticOrder S; S.init(T_TOK, 2048, G, c);
            pg8::EpiBf E{(bf16_t*)(ws + WS_QY), 2048}; pg8::gemm_phase<pg8::EpiBf, StaticOrder>(L, g, S, E, nullptr); }
        SEAM(pb + 7);
        if (IN(pb + 8) && KIND(9)) peer_topk_phase(p, L, l, G, c);
        SEAM(pb + 8);
        if (IN(pb + 9) && KIND(10)) peer_u_phase(p, l, G, c);
        SEAM(pb + 9);
        if (IN(pb + 10) && KIND(11)) peer_v_phase(p, L, l, p.out, G, c);
        SEAM(pb + 10);
        if (IN(pb + 11) && KIND(12)) { if (l + 1 < NLAYER) rmsnorm_phase<true>(p.out, p.norm_mix + (l + 1) * 1024, H, G, c); else rmsnorm_phase<false>(p.out, p.norm_final, p.out, G, c); }
        SEAM(pb + 11);
    }
#undef IN
#undef SEAM
}

extern "C" void kernel_launch(void* const* d_in, const int* in_sizes, int n_in, void* d_out, int out_size, void* d_ws, size_t ws_size, hipStream_t stream) {
    static int grid = 0;
    if (grid == 0) {
        if (n_in != 16 || out_size != T_TOK * DM || ws_size < WS_END) { fprintf(stderr, "kernel_launch: unexpected shapes (n_in %d, out %d, ws %zu < %zu)\n", n_in, out_size, ws_size, (size_t)WS_END); grid = -1; return; }
        int dev = 0, cus = 0, per_cu = 0;
        if (hipGetDevice(&dev) != hipSuccess || hipDeviceGetAttribute(&cus, hipDeviceAttributeMultiprocessorCount, dev) != hipSuccess) { grid = -1; return; }
        if (hipFuncSetAttribute((const void*)mega_fwd, hipFuncAttributeMaxDynamicSharedMemorySize, LDS_BYTES) != hipSuccess) { fprintf(stderr, "kernel_launch: hipFuncSetAttribute failed\n"); grid = -1; return; }
        if (hipOccupancyMaxActiveBlocksPerMultiprocessor(&per_cu, (const void*)mega_fwd, 512, LDS_BYTES) != hipSuccess || per_cu < 1) { fprintf(stderr, "kernel_launch: occupancy query says %d\n", per_cu); (void)hipGetLastError(); grid = -1; return; }
        grid = cus;
    }
    if (grid < 0) return;
    (void)hipMemsetAsync((char*)d_ws + WS_CTL, 0, CTL_BYTES, stream);
    Params p{};
    p.x = (const float*)d_in[0]; p.w_in = (const float*)d_in[1]; p.sinks = (const float*)d_in[2]; p.alpha_w = (const float*)d_in[3]; p.alpha_b = (const float*)d_in[4]; p.head_norm = (const float*)d_in[5];
    p.w_branch = (const float*)d_in[6]; p.w_out = (const float*)d_in[7]; p.norm_mix = (const float*)d_in[8]; p.norm_ffn = (const float*)d_in[9]; p.peer_wq = (const float*)d_in[10]; p.peer_keys = (const float*)d_in[11];
    p.peer_u = (const float*)d_in[12]; p.peer_v = (const float*)d_in[13]; p.rel_bias = (const float*)d_in[14]; p.norm_final = (const float*)d_in[15];
    p.out = (float*)d_out; p.ws = (unsigned char*)d_ws;
#if MK_PER_PHASE
    for (int k = 0; k < N_PHASES; ++k) { p.ph_lo = k; p.ph_hi = k + 1; hipLaunchKernelGGL(mega_fwd, dim3(grid), dim3(512), LDS_BYTES, stream, p); }
#else
    p.ph_lo = 0; p.ph_hi = N_PHASES;
    hipLaunchKernelGGL(mega_fwd, dim3(grid), dim3(512), LDS_BYTES, stream, p);
#endif
}
```

```cpp
#include <hip/hip_runtime.h>
#include <cstdio>
#include <cstdint>

#define LAS __attribute__((address_space(3)))
typedef unsigned short bf16_t;
typedef short bf16x8 __attribute__((ext_vector_type(8)));
typedef float f32x4 __attribute__((ext_vector_type(4)));
typedef float f32x2 __attribute__((ext_vector_type(2)));
typedef unsigned u32x4 __attribute__((ext_vector_type(4)));
typedef unsigned u32x2 __attribute__((ext_vector_type(2)));

constexpr int T_TOK = 16384, DM = 1024, SEQ = 2048, NBATCH = 8, NLAYER = 2;
constexpr int NP = 10240;
constexpr int C_QA = 0, C_KA = 512, C_VA = 640;
constexpr int C_B0 = 768;
constexpr int C_QC = 5376, C_KC = 5632, C_VC = 5888, C_RC = 6400, C_Z = 6912, C_G = 7168;
constexpr int IN_W = 10000;
constexpr int NEXP = 16384;

constexpr size_t WS_CTL   = 0;
constexpr size_t CTL_BYTES = 65536;
constexpr size_t WS_LUT   = WS_CTL + CTL_BYTES;
constexpr size_t WS_DECAY = WS_LUT + 32768;
constexpr size_t WS_LSE   = WS_DECAY + 262144;
constexpr size_t WS_USC   = WS_LSE + 1572864;
constexpr size_t WS_VSC   = WS_USC + 131072;
constexpr size_t WS_WSC   = WS_VSC + 131072;
constexpr size_t WS_HSC   = WS_WSC + 131072;
constexpr size_t WS_XSC   = WS_HSC + 65536;
constexpr size_t WS_WQSC  = WS_XSC + 65536;
constexpr size_t WS_TSC   = WS_WQSC + 16384;
constexpr size_t WS_P     = WS_TSC + 65536;
constexpr size_t WS_H     = WS_P + (size_t)T_TOK * NP * 2;
constexpr size_t WS_SPREV = WS_H + (size_t)T_TOK * DM * 2;
constexpr size_t WS_XQ    = WS_SPREV;
constexpr size_t WS_WIN   = WS_SPREV + 16777216;
constexpr size_t WS_WBR   = WS_WIN + (size_t)2 * NP * 1024 * 2;
constexpr size_t WS_WOUT  = WS_WBR + (size_t)2 * 3 * 1024 * 512 * 2;
constexpr size_t WS_WQ    = WS_WOUT + (size_t)2 * 1024 * 1024 * 2;
constexpr size_t WS_KEYS  = WS_WQ + (size_t)2 * 2048 * 1024 * 2;
constexpr size_t WS_U8    = WS_KEYS + (size_t)2 * 8 * 2 * 128 * 128 * 2;
constexpr size_t WS_V8    = WS_U8 + (size_t)2 * NEXP * 1024;
constexpr size_t WS_END   = WS_V8 + (size_t)2 * NEXP * 1024;
constexpr size_t WS_QY    = WS_P;
constexpr size_t WS_IDX   = WS_QY + (size_t)T_TOK * 2048 * 2;
constexpr size_t WS_GATE  = WS_IDX + (size_t)T_TOK * 128 * 4;
constexpr size_t WS_HIDP  = WS_GATE + (size_t)T_TOK * 128 * 4;
constexpr size_t WS_EW    = WS_HIDP + (size_t)T_TOK * 128 * 8 * 4;
static_assert(WS_EW + (size_t)T_TOK * 128 * 8 <= WS_H, "peer alias");
static_assert(WS_END <= (size_t)536870912, "workspace");

constexpr int LDS_BYTES = 147456;
constexpr int LDS_MISC = 131072;

struct Params {
    const float *x, *w_in, *sinks, *alpha_w, *alpha_b, *head_norm, *w_branch, *w_out, *norm_mix, *norm_ffn, *peer_wq, *peer_keys, *peer_u, *peer_v, *rel_bias, *norm_final;
    float* out; unsigned char* ws; int ph_lo, ph_hi;
};

__device__ __forceinline__ float bf2f(unsigned short b) { return __uint_as_float(((unsigned)b) << 16); }
__device__ __forceinline__ float bflo(unsigned u) { return __uint_as_float(u << 16); }
__device__ __forceinline__ float bfhi(unsigned u) { return __uint_as_float(u & 0xffff0000u); }
__device__ __forceinline__ unsigned cvt_pk_bf16(float lo, float hi) { unsigned r; asm("v_cvt_pk_bf16_f32 %0, %1, %2" : "=v"(r) : "v"(lo), "v"(hi)); return r; }
__device__ __forceinline__ float fexp(float x) { return __builtin_amdgcn_exp2f(x * 1.4426950408889634f); }
__device__ __forceinline__ float flog(float x) { return __builtin_amdgcn_logf(x) * 0.6931471805599453f; }
__device__ __forceinline__ float fsigmoid(float x) { return __builtin_amdgcn_rcpf(1.0f + fexp(-x)); }
__device__ __forceinline__ float flogsigmoid(float z) { return fminf(z, 0.f) - flog(1.0f + fexp(-fabsf(z))); }
__device__ __forceinline__ float fgelu_tanh(float x) { const float u = 0.7978845608028654f * (x + 0.044715f * x * x * x); return x * fsigmoid(2.0f * u); }
__device__ __forceinline__ float wave_sum(float v) {
#pragma unroll
    for (int o = 32; o >= 1; o >>= 1) v += __shfl_xor(v, o);
    return v;
}
__device__ __forceinline__ float wave_max(float v) {
#pragma unroll
    for (int o = 32; o >= 1; o >>= 1) v = fmaxf(v, __shfl_xor(v, o));
    return v;
}
__device__ __forceinline__ size_t pidx(size_t row, int col) { return ((size_t)(col >> 6) * T_TOK + row) * 64 + (size_t)(col & 63); }
#define WG_SYNC() __syncthreads()
__device__ __forceinline__ unsigned pack_i8x4(float a, float b, float c, float d) {
    const int ia = (int)__builtin_rintf(a), ib = (int)__builtin_rintf(b), ic = (int)__builtin_rintf(c), id = (int)__builtin_rintf(d);
    return (unsigned)(ia & 0xff) | ((unsigned)(ib & 0xff) << 8) | ((unsigned)(ic & 0xff) << 16) | ((unsigned)id << 24); }
__device__ __forceinline__ int opaque_tid() { int t = (int)threadIdx.x; asm volatile("" : "+v"(t)); return t; }


#define XB_TMO      128
#define XB_XCNT(j)  (256  + 64 * (j))
#define XB_XSUB(j)  (1280 + 64 * (j))
#define XB_XGEN(j)  (2304 + 64 * (j))
#define XB_TOP      3328
#define XB_TOPGEN   3392
#define XCD_BAR_WORDS 3456
#define XB_SPIN_CAP (1u << 18)

__device__ __forceinline__ unsigned xb_ld(unsigned* p)              { return __hip_atomic_load(p, __ATOMIC_RELAXED, __HIP_MEMORY_SCOPE_AGENT); }
__device__ __forceinline__ unsigned xb_add(unsigned* p, unsigned v) { return __hip_atomic_fetch_add(p, v, __ATOMIC_RELAXED, __HIP_MEMORY_SCOPE_AGENT); }
__device__ __forceinline__ unsigned xb_xcc_id() { return (unsigned)__builtin_amdgcn_s_getreg((3 << 11) | 20) & 0xFu; }
#define XB_SPIN(cond, bar) do { unsigned _sp = 0; while (cond) { __builtin_amdgcn_s_sleep(1); \
    if ((++_sp & 255u) == 0u) { if (xb_ld(&(bar)[XB_TMO])) break; if (_sp > XB_SPIN_CAP) { atomicAdd(&(bar)[XB_TMO], 1u); break; } } } } while (0)

struct XcdBarrier {
    unsigned* bar; unsigned x;
    volatile LAS unsigned* st;
};

__device__ __forceinline__ XcdBarrier xcd_barrier_post(unsigned* bar, volatile LAS unsigned* st) {
    XcdBarrier b; b.bar = bar; b.x = xb_xcc_id(); b.st = st;
    if (threadIdx.x == 0) (void)xb_add(&bar[XB_XCNT(b.x)], 1u);
    return b;
}
__device__ __forceinline__ void xcd_barrier_complete(unsigned* bar, unsigned x, unsigned& nloc, unsigned& nx) {
    const unsigned G = gridDim.x * gridDim.y * gridDim.z;
    unsigned sum, cnt, mine, sp = 0u;
    for (;;) {
        sum = 0u; cnt = 0u; mine = 0u;
#pragma unroll
        for (unsigned j = 0; j < 16; ++j) { const unsigned c = xb_ld(&bar[XB_XCNT(j)]); sum += c; cnt += (c > 0u) ? 1u : 0u; mine = (j == x) ? c : mine; }
        if (sum == G) break;
        __builtin_amdgcn_s_sleep(1);
        if ((++sp & 255u) == 0u) { if (xb_ld(&bar[XB_TMO])) break; if (sp > XB_SPIN_CAP) { atomicAdd(&bar[XB_TMO], 1u); break; } }
    }
    nloc = mine > 0u ? mine : 1u; nx = cnt > 0u ? cnt : 1u;
}

__device__ __forceinline__ void xcd_barrier(const XcdBarrier& b) {
    asm volatile("s_waitcnt vmcnt(0)" ::: "memory");
    __syncthreads();
    if (threadIdx.x == 0) {
        unsigned* bar = b.bar;
        __builtin_amdgcn_s_waitcnt(0);
        unsigned nloc = b.st[0], nx = b.st[1];
        if (nloc == 0u) { xcd_barrier_complete(bar, b.x, nloc, nx); b.st[0] = nloc; b.st[1] = nx; }
        const unsigned old = xb_add(&bar[XB_XSUB(b.x)], 1u);
        const unsigned gen = old / nloc;
        if (old + 1u == (gen + 1u) * nloc) {
            __builtin_amdgcn_fence(__ATOMIC_RELEASE, "agent");
            asm volatile("s_waitcnt vmcnt(0)" ::: "memory");
            const unsigned og = xb_add(&bar[XB_TOP], 1u);
            const unsigned tg = og / nx;
            if (og + 1u == (tg + 1u) * nx) xb_add(&bar[XB_TOPGEN], 1u);
            else XB_SPIN(xb_ld(&bar[XB_TOPGEN]) == tg, bar);
            __builtin_amdgcn_fence(__ATOMIC_ACQUIRE, "agent");
            xb_add(&bar[XB_XGEN(b.x)], 1u);
            asm volatile("s_waitcnt vmcnt(0)" ::: "memory");
        } else {
            XB_SPIN(xb_ld(&bar[XB_XGEN(b.x)]) == gen, bar);
            __builtin_amdgcn_fence(__ATOMIC_ACQUIRE, "agent");
            asm volatile("s_waitcnt vmcnt(0)" ::: "memory");
        }
    }
    __syncthreads();
}

namespace pg8 {
#define PG8_LAS __attribute__((address_space(3)))
constexpr int BM = 256, BK = 64, HALF = 128, HTB = HALF * BK * 2  , STAGE_BYTES = 8 * HTB, NXCD = 8, WGM = 8;

__host__ __device__ __forceinline__ int lds_byte(int r, int c) { const int st = (r >> 4) * 2 + (c >> 5), rr = r & 15, cc = c & 31, ob = rr * 64 + cc * 2; return st * 1024 + (ob ^ (((ob >> 9) & 1) << 5)); }
__host__ __device__ __forceinline__ void stage_rc(int b, int& R, int& C) { const int st = b / 1024, sb = b % 1024, swz = sb ^ (((sb >> 9) & 1) << 5); R = (st >> 1) * 16 + swz / 64; C = (st & 1) * 32 + (swz % 64) / 2; }
__host__ __device__ __forceinline__ int perm32(int rho) { const int n = rho >> 4, i = rho & 15; return 8 * (i >> 2) + 4 * n + (i & 3); }

struct Unit { int pm, pn, z; };
struct Gemm { const bf16_t* A; const bf16_t* Bt; int M, N, K, lda, ldb; size_t ksA; };

struct StaticOrder {
    int nM, nN, nwg, G, c;
    __host__ __device__ void init(int M, int N, int G_, int c_) { nM = M / BM; nN = N / BM; nwg = nM * nN; G = G_; c = c_; }
    __host__ __device__ bool next(int i, Unit& u) const {
        const long L = (long)i * G + c; if (L >= nwg) return false;
        int wgid = (int)L; { const int q = nwg / NXCD, r = nwg % NXCD, xcd = wgid % NXCD, off = wgid / NXCD; wgid = (xcd < r ? xcd * (q + 1) : r * (q + 1) + (xcd - r) * q) + off; }
        const int nig = WGM * nN, gid = wgid / nig, fm = gid * WGM, gsz = (nM - fm) < WGM ? (nM - fm) : WGM;
        u.pm = fm + ((wgid % nig) % gsz); u.pn = (wgid % nig) / gsz; u.z = 0; return true;
    }
    __device__ __forceinline__ const char* ptrA(const Gemm& g, const Unit& u) const { return (const char*)g.A + (size_t)u.pm * BM * g.lda * 2; }
    __device__ __forceinline__ const char* ptrB(const Gemm& g, const Unit& u) const { return (const char*)g.Bt + (size_t)u.pn * BM * g.ldb * 2; }
    __device__ __forceinline__ void a_ready(const Unit&) const {}
    __device__ __forceinline__ void done(const Unit&) const {}
};


typedef int v8i_t __attribute__((ext_vector_type(8)));
typedef int v4i_t __attribute__((ext_vector_type(4)));
__device__ __forceinline__ v8i_t cat8(bf16x8 a, bf16x8 b) { const v4i_t x = __builtin_bit_cast(v4i_t, a), y = __builtin_bit_cast(v4i_t, b); return __builtin_shufflevector(x, y, 0, 1, 2, 3, 4, 5, 6, 7); }

struct EpiIn {
    static constexpr bool PERM = true, AFTER_DRAIN = false;
    bf16_t* O; const float* zbias; const float* wsc; const float* hsc;
    __device__ __forceinline__ void operator()(const f32x4 (&acc)[2][2][4][2], const Unit& u, int wr, int wc, int fr, int fq) const {
        const int row0 = u.pm * BM + wr * 64 + fr; const int cin = wc * 32 + 8 * fq; const int col0 = u.pn * BM + cin;
        const int mode = (u.pn >= 28) ? 2 : (u.pn == 27 ? 1 : 0);
        f32x4 bv[2][2], sv[2][2];
#pragma unroll
        for (int bj = 0; bj < 2; ++bj)
#pragma unroll
            for (int n = 0; n < 2; ++n) { bv[bj][n] = (mode == 1) ? *(const f32x4*)(zbias + cin + bj * HALF + 4 * n) : (f32x4){0.f, 0.f, 0.f, 0.f}; sv[bj][n] = *(const f32x4*)(wsc + col0 + bj * HALF + 4 * n); }
        float hsv[2][4];
#pragma unroll
        for (int ai = 0; ai < 2; ++ai)
#pragma unroll
            for (int m = 0; m < 4; ++m) hsv[ai][m] = hsc[row0 + ai * HALF + m * 16];
#pragma unroll
        for (int ai = 0; ai < 2; ++ai)
#pragma unroll
            for (int m = 0; m < 4; ++m) { const size_t orow = (size_t)(row0 + ai * HALF + m * 16); const float hs = hsv[ai][m];
#pragma unroll
                for (int bj = 0; bj < 2; ++bj) { const v4i_t i0 = __builtin_bit_cast(v4i_t, acc[ai][bj][m][0]), i1 = __builtin_bit_cast(v4i_t, acc[ai][bj][m][1]);
                    f32x4 v0 = (f32x4){(float)i0[0], (float)i0[1], (float)i0[2], (float)i0[3]} * (sv[bj][0] * hs) + bv[bj][0], v1 = (f32x4){(float)i1[0], (float)i1[1], (float)i1[2], (float)i1[3]} * (sv[bj][1] * hs) + bv[bj][1];
                    if (mode == 2) {
#pragma unroll
                        for (int j = 0; j < 4; ++j) { v0[j] = fsigmoid(v0[j]); v1[j] = fsigmoid(v1[j]); } }
                    if (mode == 1) {
#pragma unroll
                        for (int j = 0; j < 4; ++j) { v0[j] = flogsigmoid(v0[j]) * 0.0625f; v1[j] = flogsigmoid(v1[j]) * 0.0625f; } }
                    u32x4 w; w.x = cvt_pk_bf16(v0[0], v0[1]); w.y = cvt_pk_bf16(v0[2], v0[3]); w.z = cvt_pk_bf16(v1[0], v1[1]); w.w = cvt_pk_bf16(v1[2], v1[3]);
                    __builtin_nontemporal_store(w, (u32x4*)(O + pidx(orow, col0 + bj * HALF))); } }
    }
};
struct EpiBf {
    static constexpr bool PERM = true, AFTER_DRAIN = false;
    bf16_t* O; int ldc;
    __device__ __forceinline__ void operator()(const f32x4 (&acc)[2][2][4][2], const Unit& u, int wr, int wc, int fr, int fq) const {
        const int row0 = u.pm * BM + wr * 64 + fr; const int col0 = u.pn * BM + wc * 32 + 8 * fq;
#pragma unroll
        for (int ai = 0; ai < 2; ++ai)
#pragma unroll
            for (int m = 0; m < 4; ++m) { bf16_t* rowp = O + (size_t)(row0 + ai * HALF + m * 16) * ldc + col0;
#pragma unroll
                for (int bj = 0; bj < 2; ++bj) { const f32x4 v0 = acc[ai][bj][m][0], v1 = acc[ai][bj][m][1];
                    u32x4 w; w.x = cvt_pk_bf16(v0[0], v0[1]); w.y = cvt_pk_bf16(v0[2], v0[3]); w.z = cvt_pk_bf16(v1[0], v1[1]); w.w = cvt_pk_bf16(v1[2], v1[3]);
                    *(u32x4*)(rowp + bj * HALF) = w; } }
    }
};
struct EpiBfI8 {
    static constexpr bool PERM = true, AFTER_DRAIN = false;
    bf16_t* O; int ldc; const float* wsc; const float* hsc;
    __device__ __forceinline__ void operator()(const f32x4 (&acc)[2][2][4][2], const Unit& u, int wr, int wc, int fr, int fq) const {
        const int row0 = u.pm * BM + wr * 64 + fr; const int col0 = u.pn * BM + wc * 32 + 8 * fq;
        f32x4 sv[2][2];
#pragma unroll
        for (int bj = 0; bj < 2; ++bj)
#pragma unroll
            for (int n = 0; n < 2; ++n) sv[bj][n] = *(const f32x4*)(wsc + col0 + bj * HALF + 4 * n);
        float hsv[2][4];
#pragma unroll
        for (int ai = 0; ai < 2; ++ai)
#pragma unroll
            for (int m = 0; m < 4; ++m) hsv[ai][m] = hsc[row0 + ai * HALF + m * 16];
#pragma unroll
        for (int ai = 0; ai < 2; ++ai)
#pragma unroll
            for (int m = 0; m < 4; ++m) { bf16_t* rowp = O + (size_t)(row0 + ai * HALF + m * 16) * ldc + col0; const float hs = hsv[ai][m];
#pragma unroll
                for (int bj = 0; bj < 2; ++bj) { const v4i_t i0 = __builtin_bit_cast(v4i_t, acc[ai][bj][m][0]), i1 = __builtin_bit_cast(v4i_t, acc[ai][bj][m][1]);
                    const f32x4 v0 = (f32x4){(float)i0[0], (float)i0[1], (float)i0[2], (float)i0[3]} * (sv[bj][0] * hs), v1 = (f32x4){(float)i1[0], (float)i1[1], (float)i1[2], (float)i1[3]} * (sv[bj][1] * hs);
                    u32x4 w; w.x = cvt_pk_bf16(v0[0], v0[1]); w.y = cvt_pk_bf16(v0[2], v0[3]); w.z = cvt_pk_bf16(v1[0], v1[1]); w.w = cvt_pk_bf16(v1[2], v1[3]);
                    *(u32x4*)(rowp + bj * HALF) = w; } }
    }
};
struct EpiMerge {
    static constexpr bool PERM = true, AFTER_DRAIN = false;
    const bf16_t* Pm; bf16_t* MG;
    __device__ __forceinline__ void operator()(const f32x4 (&acc)[2][2][4][2], const Unit& u, int wr, int wc, int fr, int fq) const {
        const int row0 = u.pm * BM + wr * 64 + fr; const int col0 = u.pn * BM + wc * 32 + 8 * fq; const int z = u.z;
#pragma unroll
        for (int ai = 0; ai < 2; ++ai) {
            u32x4 gw[4][2], pw[4][2];
#pragma unroll
            for (int m = 0; m < 4; ++m) { const int row = row0 + ai * HALF + m * 16;
                const bf16_t* mp = MG + (size_t)row * DM + col0;
#pragma unroll
                for (int bj = 0; bj < 2; ++bj) { gw[m][bj] = *(const u32x4*)(Pm + pidx((size_t)row, C_G + 1024 * z + col0 + bj * HALF)); pw[m][bj] = (z > 0) ? *(const u32x4*)(mp + bj * HALF) : (u32x4){0u, 0u, 0u, 0u}; } }
#pragma unroll
            for (int m = 0; m < 4; ++m) { const int row = row0 + ai * HALF + m * 16; bf16_t* mp = MG + (size_t)row * DM + col0;
#pragma unroll
                for (int bj = 0; bj < 2; ++bj) { const u32x4 g = gw[m][bj], q = pw[m][bj]; const f32x4 v0 = acc[ai][bj][m][0], v1 = acc[ai][bj][m][1];
                    u32x4 w;
                    w.x = cvt_pk_bf16(bflo(q.x) + bflo(g.x) * v0[0], bfhi(q.x) + bfhi(g.x) * v0[1]); w.y = cvt_pk_bf16(bflo(q.y) + bflo(g.y) * v0[2], bfhi(q.y) + bfhi(g.y) * v0[3]);
                    w.z = cvt_pk_bf16(bflo(q.z) + bflo(g.z) * v1[0], bfhi(q.z) + bfhi(g.z) * v1[1]); w.w = cvt_pk_bf16(bflo(q.w) + bflo(g.w) * v1[2], bfhi(q.w) + bfhi(g.w) * v1[3]);
                    *(u32x4*)(mp + bj * HALF) = w; } }
        }
    }
};
struct EpiResid {
    static constexpr bool PERM = false, AFTER_DRAIN = false;
    const float* src; float* dst;
    __device__ __forceinline__ void operator()(const f32x4 (&acc)[2][2][4][2], const Unit& u, int wr, int wc, int fr, int fq) const {
        const int row0 = u.pm * BM + wr * 64 + fr, col0 = u.pn * BM + wc * 32 + 4 * fq;
#pragma unroll
        for (int ai = 0; ai < 2; ++ai) {
            f32x4 b[4][2][2];
#pragma unroll
            for (int m = 0; m < 4; ++m) { const size_t off = (size_t)(row0 + ai * HALF + m * 16) * DM + col0;
#pragma unroll
                for (int bj = 0; bj < 2; ++bj)
#pragma unroll
                    for (int n = 0; n < 2; ++n) b[m][bj][n] = *(const f32x4*)(src + off + bj * HALF + n * 16); }
#pragma unroll
            for (int m = 0; m < 4; ++m) { const size_t off = (size_t)(row0 + ai * HALF + m * 16) * DM + col0;
#pragma unroll
                for (int bj = 0; bj < 2; ++bj)
#pragma unroll
                    for (int n = 0; n < 2; ++n) *(f32x4*)(dst + off + bj * HALF + n * 16) = b[m][bj][n] + acc[ai][bj][m][n]; }
        }
    }
};

template <class Epi, class Sched, int MODE = 0, bool STAMP = false>
__device__ __forceinline__ void gemm_phase(PG8_LAS unsigned char* lds, const Gemm g, const Sched& S, const Epi& E, unsigned long long* stamps) {
    const int tid = opaque_tid(), wid = __builtin_amdgcn_readfirstlane(tid >> 6), lane = tid & 63, wr = wid >> 2, wc = wid & 3, fr = lane & 15, fq = lane >> 4;
    const int K = g.K, nt = K / BK;
    int ts_lo = 0, ts_hi = 0, nts = 0; const unsigned long long rt_entry = STAMP ? (unsigned long long)wall_clock64() : 0ull;
#define PG8_STAMP() do { if (STAMP && wid == 0 && nts < 64) { const unsigned long long _c = (unsigned long long)clock64(); \
        ts_lo = (lane == nts) ? (int)(unsigned)_c : ts_lo; ts_hi = (lane == nts) ? (int)(unsigned)(_c >> 32) : ts_hi; ++nts; } } while (0)
    PG8_STAMP();
    unsigned voffA[2], voffB[2];
#pragma unroll
    for (int i = 0; i < 2; ++i) { int R, C; stage_rc(tid * 16 + i * 8192, R, C); const int Rb = Epi::PERM ? ((R & ~31) + perm32(R & 31)) : R;
        voffA[i] = (unsigned)(R * g.lda + C) * 2u; voffB[i] = (unsigned)(Rb * g.ldb + C) * 2u; }
    const size_t kstepB = (size_t)(BK * 2), kstepA = g.ksA ? g.ksA : (size_t)(BK * 2);
    const size_t hstepA = (size_t)HALF * g.lda * 2, hstepB = (size_t)HALF * g.ldb * 2;
    const unsigned ldsw = (unsigned)wid * 1024u;
    const int aoff = lds_byte(wr * 64 + fr, fq * 8), boff = lds_byte(wc * 32 + fr, fq * 8);
#define PG8_SA(b, h) (((b) * 2 + (h)) * HTB)
#define PG8_SB(b, h) ((4 + (b) * 2 + (h)) * HTB)
#define PG8_STAGE(bufoff, gbase, voff) do { _Pragma("unroll") for (int _i = 0; _i < 2; ++_i) \
        __builtin_amdgcn_global_load_lds((const unsigned*)((const char*)(gbase) + (voff)[_i]), (PG8_LAS unsigned*)(lds + (bufoff) + ldsw + _i * 8192), 16, 0, 0); } while (0)
#define PG8_LDA(dst, b, h) do { _Pragma("unroll") for (int m = 0; m < 4; ++m) _Pragma("unroll") for (int k = 0; k < 2; ++k) dst[m][k] = *(const PG8_LAS bf16x8*)(lds + PG8_SA(b, h) + aoff + m * 2048 + k * 1024); } while (0)
#define PG8_LDB(dst, b, h) do { _Pragma("unroll") for (int n = 0; n < 2; ++n) _Pragma("unroll") for (int k = 0; k < 2; ++k) dst[n][k] = *(const PG8_LAS bf16x8*)(lds + PG8_SB(b, h) + boff + n * 2048 + k * 1024); } while (0)
#define PG8_MMA(ai, bj, At, Bt) do { __builtin_amdgcn_s_setprio(1); _Pragma("unroll") for (int m = 0; m < 4; ++m) _Pragma("unroll") for (int n = 0; n < 2; ++n) { \
        if constexpr (MODE == 1) { asm volatile("v_mfma_f32_16x16x128_f8f6f4 %0, %1, %2, %0" : "+v"(acc[ai][bj][m][n]) : "v"(cat8(Bt[n][0], Bt[n][1])), "v"(cat8(At[m][0], At[m][1]))); } \
        else if constexpr (MODE == 2) { _Pragma("unroll") for (int k = 0; k < 2; ++k) acc[ai][bj][m][n] = __builtin_bit_cast(f32x4, __builtin_amdgcn_mfma_i32_16x16x64_i8(__builtin_bit_cast(v4i_t, Bt[n][k]), __builtin_bit_cast(v4i_t, At[m][k]), __builtin_bit_cast(v4i_t, acc[ai][bj][m][n]), 0, 0, 0)); } \
        else { _Pragma("unroll") for (int k = 0; k < 2; ++k) acc[ai][bj][m][n] = __builtin_amdgcn_mfma_f32_16x16x32_bf16(Bt[n][k], At[m][k], acc[ai][bj][m][n], 0, 0, 0); } } \
        __builtin_amdgcn_s_setprio(0); } while (0)
#define PG8_WAIT_V(n) asm volatile("s_waitcnt vmcnt(" #n ")" ::: "memory")
#define PG8_WAIT_L(n) asm volatile("s_waitcnt lgkmcnt(" #n ")" ::: "memory")
#define PG8_BAR __builtin_amdgcn_s_barrier()
#define PG8_SCHED __builtin_amdgcn_sched_barrier(0)
    Unit cur, nxt; int ui = 0;
    if (!S.next(0, cur)) return;
    f32x4 acc[2][2][4][2];
#pragma unroll
    for (int a = 0; a < 2; ++a)
#pragma unroll
        for (int b = 0; b < 2; ++b)
#pragma unroll
            for (int m = 0; m < 4; ++m)
#pragma unroll
                for (int n = 0; n < 2; ++n) acc[a][b][m][n] = (f32x4){0.f, 0.f, 0.f, 0.f};
    bf16x8 At[4][2], B0[2][2], B1[2][2];
    const char* cA = S.ptrA(g, cur); const char* cB = S.ptrB(g, cur);
    S.a_ready(cur);
    PG8_STAGE(PG8_SB(0, 0), cB, voffB); PG8_STAGE(PG8_SA(0, 0), cA, voffA); PG8_STAGE(PG8_SB(0, 1), cB + hstepB, voffB); PG8_STAGE(PG8_SA(0, 1), cA + hstepA, voffA);
    if (wr == 1) PG8_BAR;
    PG8_WAIT_V(4); PG8_BAR;
    PG8_STAGE(PG8_SB(1, 0), cB + kstepB, voffB); PG8_STAGE(PG8_SA(1, 0), cA + kstepA, voffA); PG8_STAGE(PG8_SB(1, 1), cB + hstepB + kstepB, voffB);
    PG8_WAIT_V(6); PG8_BAR;
    PG8_STAMP();
    for (;;) {
        const bool has_next = S.next(ui + 1, nxt);
        const char* nA = has_next ? S.ptrA(g, nxt) : cA; const char* nB = has_next ? S.ptrB(g, nxt) : cB;
#pragma nounroll
        for (int t = 0; t < nt; t += 2) {
            const bool last = (t == nt - 2);
            const char* a1 = cA + (size_t)(t + 1) * kstepA;
            const char* a2 = last ? nA : cA + (size_t)(t + 2) * kstepA; const char* b2 = last ? nB : cB + (size_t)(t + 2) * kstepB;
            const char* a3 = a2 + kstepA; const char* b3 = b2 + kstepB;
            if (last && has_next) S.a_ready(nxt);
            PG8_LDB(B0, 0, 0); PG8_SCHED; PG8_LDA(At, 0, 0); PG8_STAGE(PG8_SA(1, 1), a1 + hstepA, voffA);
            PG8_WAIT_L(8); PG8_BAR; PG8_WAIT_L(0); PG8_MMA(0, 0, At, B0); PG8_BAR; PG8_SCHED;
            PG8_LDB(B1, 0, 1); PG8_STAGE(PG8_SB(0, 0), b2, voffB);
            PG8_BAR; PG8_WAIT_L(0); PG8_MMA(0, 1, At, B1); PG8_BAR;
            PG8_LDA(At, 0, 1); PG8_STAGE(PG8_SA(0, 0), a2, voffA);
            PG8_BAR; PG8_WAIT_L(0); PG8_MMA(1, 0, At, B0); PG8_BAR; PG8_SCHED;
            PG8_STAGE(PG8_SB(0, 1), b2 + hstepB, voffB);
            PG8_WAIT_V(6); PG8_BAR; PG8_MMA(1, 1, At, B1); PG8_BAR;
            PG8_LDB(B0, 1, 0); PG8_SCHED; PG8_LDA(At, 1, 0); PG8_STAGE(PG8_SA(0, 1), a2 + hstepA, voffA);
            PG8_WAIT_L(8); PG8_BAR; PG8_WAIT_L(0); PG8_MMA(0, 0, At, B0); PG8_BAR; PG8_SCHED;
            PG8_LDB(B1, 1, 1); PG8_STAGE(PG8_SB(1, 0), b3, voffB);
            PG8_BAR; PG8_WAIT_L(0); PG8_MMA(0, 1, At, B1); PG8_BAR;
            PG8_LDA(At, 1, 1); PG8_STAGE(PG8_SA(1, 0), a3, voffA);
            PG8_BAR; PG8_WAIT_L(0); PG8_MMA(1, 0, At, B0); PG8_BAR; PG8_SCHED;
            PG8_STAGE(PG8_SB(1, 1), b3 + hstepB, voffB);
            PG8_WAIT_V(6); PG8_BAR; PG8_MMA(1, 1, At, B1); PG8_BAR;
        }
        if constexpr (MODE == 1) asm volatile("s_nop 15\n\ts_nop 15" ::: "memory");
        PG8_STAMP();
        if constexpr (!Epi::AFTER_DRAIN) { E(acc, cur, wr, wc, fr, fq); S.done(cur); }
        PG8_STAMP();
        if (!has_next) break;
#pragma unroll
        for (int a = 0; a < 2; ++a)
#pragma unroll
            for (int b = 0; b < 2; ++b)
#pragma unroll
                for (int m = 0; m < 4; ++m)
#pragma unroll
                    for (int n = 0; n < 2; ++n) acc[a][b][m][n] = (f32x4){0.f, 0.f, 0.f, 0.f};
        cur = nxt; cA = nA; cB = nB; ++ui;
    }
    PG8_WAIT_V(0);
    if (wr == 0) PG8_BAR;
    PG8_BAR;
    if constexpr (Epi::AFTER_DRAIN) { E.fused(acc, cur, wr, wc, fr, fq, lds, wid, lane); S.done(cur); }
    PG8_STAMP();
    if (STAMP && wid == 0) { stamps[lane] = lane < nts ? (((unsigned long long)(unsigned)ts_hi << 32) | (unsigned)ts_lo) : 0ull;
        if (lane == 62) stamps[62] = rt_entry; if (lane == 63) stamps[63] = (unsigned long long)wall_clock64(); }
#undef PG8_STAMP
#undef PG8_SA
#undef PG8_SB
#undef PG8_STAGE
#undef PG8_LDA
#undef PG8_LDB
#undef PG8_MMA
#undef PG8_WAIT_V
#undef PG8_WAIT_L
#undef PG8_BAR
#undef PG8_SCHED
}
}

using pg8::Unit; using pg8::Gemm; using pg8::StaticOrder;

struct MergeOrder : StaticOrder {
    __device__ __forceinline__ bool next(int i, Unit& u) const { if (!StaticOrder::next(i / 3, u)) return false; u.z = i % 3; return true; }
    __device__ __forceinline__ const char* ptrA(const Gemm& g, const Unit& u) const { const int col = (u.z == 0) ? C_QA : (u.z == 1 ? C_B0 : C_VC); return (const char*)g.A + ((size_t)(col >> 6) * T_TOK + (size_t)u.pm * pg8::BM) * 128; }
    __device__ __forceinline__ const char* ptrB(const Gemm& g, const Unit& u) const { return (const char*)(g.Bt + (size_t)u.z * 1024 * 512) + (size_t)u.pn * pg8::BM * g.ldb * 2; }
};

template <int OUT_MODE>
__device__ __forceinline__ void rmsnorm_phase(const float* src, const float* gain, void* dst, int G, int c, float* hsc = nullptr, unsigned char* dst8 = nullptr) {
    const int tid = opaque_tid(), lane = tid & 63, wid = tid >> 6;
    f32x4 gv[4];
#pragma unroll
    for (int q = 0; q < 4; ++q) gv[q] = *(const f32x4*)(gain + 256 * q + 4 * lane);
    for (int row = c * 8 + wid; row < T_TOK; row += G * 8) {
        f32x4 v[4]; float ss = 0.f;
#pragma unroll
        for (int q = 0; q < 4; ++q) { v[q] = *(const f32x4*)(src + (size_t)row * DM + 256 * q + 4 * lane); ss += v[q][0] * v[q][0] + v[q][1] * v[q][1] + v[q][2] * v[q][2] + v[q][3] * v[q][3]; }
        ss = wave_sum(ss);
        const float r = __builtin_amdgcn_rsqf(ss * (1.0f / 1024.0f) + 1e-6f);
        if (OUT_MODE == 2 || OUT_MODE == 3) { f32x4 y[4]; float am = 0.f; unsigned char* d8 = (OUT_MODE == 3) ? dst8 : (unsigned char*)dst;
#pragma unroll
            for (int q = 0; q < 4; ++q) { y[q] = v[q] * r * gv[q]; am = fmaxf(am, fmaxf(fmaxf(fabsf(y[q][0]), fabsf(y[q][1])), fmaxf(fabsf(y[q][2]), fabsf(y[q][3])))); }
            am = wave_max(am); const float inv = am > 0.f ? 127.0f / am : 0.f;
#pragma unroll
            for (int q = 0; q < 4; ++q) { *(unsigned*)(d8 + (size_t)row * DM + 256 * q + 4 * lane) = pack_i8x4(y[q][0] * inv, y[q][1] * inv, y[q][2] * inv, y[q][3] * inv);
                if (OUT_MODE == 3) { u32x2 w; w.x = cvt_pk_bf16(y[q][0], y[q][1]); w.y = cvt_pk_bf16(y[q][2], y[q][3]); *(u32x2*)((bf16_t*)dst + (size_t)row * DM + 256 * q + 4 * lane) = w; } }
            if (lane == 0) hsc[row] = am * (1.0f / 127.0f);
        } else {
#pragma unroll
        for (int q = 0; q < 4; ++q) { const f32x4 y = v[q] * r * gv[q];
            if (OUT_MODE == 1) { u32x2 w; w.x = cvt_pk_bf16(y[0], y[1]); w.y = cvt_pk_bf16(y[2], y[3]); *(u32x2*)((bf16_t*)dst + (size_t)row * DM + 256 * q + 4 * lane) = w; }
            else *(f32x4*)((float*)dst + (size_t)row * DM + 256 * q + 4 * lane) = y; }
        }
    }
}

__device__ __forceinline__ void table_row_load(const Params& p, int tb, int l, int e, int lane, f32x4 (&v)[4]) {
    const float* src = (tb ? p.peer_v : p.peer_u) + ((size_t)l * NEXP + e) * 1024 + 16 * lane;
#pragma unroll
    for (int q = 0; q < 4; ++q) v[q] = *(const f32x4*)(src + 4 * q);
}
__device__ __forceinline__ void table_row_store(unsigned char* ws, int tb, int l, int e, int lane, const f32x4 (&v)[4]) {
    float am = 0.f;
#pragma unroll
    for (int q = 0; q < 4; ++q) am = fmaxf(am, fmaxf(fmaxf(fabsf(v[q][0]), fabsf(v[q][1])), fmaxf(fabsf(v[q][2]), fabsf(v[q][3]))));
    am = wave_max(am);
    const float qmax = tb ? 256.0f : 127.0f; const float inv = am > 0.f ? qmax / am : 0.f;
    u32x4 w; unsigned ww[4];
#pragma unroll
    for (int q = 0; q < 4; ++q) { if (tb) { int pk = __builtin_amdgcn_cvt_pk_fp8_f32(v[q][0] * inv, v[q][1] * inv, 0, false); pk = __builtin_amdgcn_cvt_pk_fp8_f32(v[q][2] * inv, v[q][3] * inv, pk, true); ww[q] = (unsigned)pk; }
        else ww[q] = pack_i8x4(v[q][0] * inv, v[q][1] * inv, v[q][2] * inv, v[q][3] * inv); }
    w.x = ww[0]; w.y = ww[1]; w.z = ww[2]; w.w = ww[3];
    *(u32x4*)(ws + (tb ? WS_V8 : WS_U8) + (((size_t)l * 8 + (lane >> 3)) * NEXP + e) * 128 + 16 * (lane & 7)) = w;
    if (lane == 0) ((float*)(ws + (tb ? WS_VSC : WS_USC)))[l * NEXP + e] = am / qmax;
}
__device__ __forceinline__ void tile_write_out(LAS float* tile, bf16_t* dst, int ld_dst, int n0, int k0) {
    const int tid = opaque_tid(), n = tid >> 3, ks = tid & 7;
    float v[8];
#pragma unroll
    for (int e = 0; e < 8; ++e) v[e] = tile[(8 * ks + e) * 65 + n];
    u32x4 w; w.x = cvt_pk_bf16(v[0], v[1]); w.y = cvt_pk_bf16(v[2], v[3]); w.z = cvt_pk_bf16(v[4], v[5]); w.w = cvt_pk_bf16(v[6], v[7]);
    *(u32x4*)(dst + (size_t)(n0 + n) * ld_dst + k0 + 8 * ks) = w;
}
__device__ __forceinline__ void transpose_tile(LAS float* tile, const float* src, int ld_src, int src_col0, int k0, bf16_t* dst, int ld_dst, int n0) {
    const int tid = opaque_tid();
#pragma unroll
    for (int q = 0; q < 2; ++q) { const int row = (tid >> 4) + 32 * q, c4 = (tid & 15) * 4;
        const f32x4 v = *(const f32x4*)(src + (size_t)(k0 + row) * ld_src + src_col0 + c4);
        tile[row * 65 + c4] = v[0]; tile[row * 65 + c4 + 1] = v[1]; tile[row * 65 + c4 + 2] = v[2]; tile[row * 65 + c4 + 3] = v[3]; }
    WG_SYNC();
    tile_write_out(tile, dst, ld_dst, n0, k0);
    WG_SYNC();
}
__device__ __forceinline__ void prologue_phase(const Params& p, LAS unsigned char* L, int G, int c) {
    const int tid = opaque_tid(), lane = tid & 63, wid = tid >> 6;
    LAS float* tile = (LAS float*)L;
    unsigned char* ws = p.ws;
    for (int it = c; it < 768; it += G) { const bool isq = it >= 640;
        const int l = isq ? (it - 640) / 64 : it / 320, n0 = isq ? ((it - 640) % 64) * 32 : (it % 320) * 32; const int kg = tid >> 3, n4 = (tid & 7) * 4;
        const int ldw = isq ? 2048 : IN_W;
        const float* src = isq ? p.peer_wq + (size_t)l * 1024 * 2048 : p.w_in + (size_t)l * 1024 * IN_W; unsigned char* dst = isq ? ws + WS_WQ + (size_t)l * 2048 * 1024 : ws + WS_WIN + (size_t)l * NP * 1024;
        float* scd = isq ? (float*)(ws + WS_WQSC) + (size_t)l * 2048 : (float*)(ws + WS_WSC) + (size_t)l * NP;
        f32x4 v[16];
        if (!isq && n0 >= C_Z && n0 < C_G) {
            const float* aw = p.alpha_w + (size_t)l * 16 * 256 + (n0 - C_Z) + n4;
            f32x4 a[16];
#pragma unroll
            for (int r2 = 0; r2 < 16; ++r2) a[r2] = *(const f32x4*)(aw + r2 * 256);
#pragma unroll
            for (int r = 0; r < 16; ++r) { const float* wr = src + (size_t)(16 * kg + r) * IN_W + 6400; f32x4 acc = (f32x4){0.f, 0.f, 0.f, 0.f};
#pragma unroll
                for (int q = 0; q < 4; ++q) { const f32x4 wv = *(const f32x4*)(wr + 4 * q); acc += a[4 * q] * wv[0]; acc += a[4 * q + 1] * wv[1]; acc += a[4 * q + 2] * wv[2]; acc += a[4 * q + 3] * wv[3]; }
                v[r] = acc; }
        } else { const int sc0 = isq ? n0 : ((n0 < C_RC) ? n0 : (n0 < C_Z ? n0 + 16 : n0 - 240));
#pragma unroll
            for (int r = 0; r < 16; ++r) v[r] = *(const f32x4*)(src + (size_t)(16 * kg + r) * ldw + sc0 + n4); }
        f32x4 am = (f32x4){0.f, 0.f, 0.f, 0.f};
#pragma unroll
        for (int r = 0; r < 16; ++r) { am[0] = fmaxf(am[0], fabsf(v[r][0])); am[1] = fmaxf(am[1], fabsf(v[r][1])); am[2] = fmaxf(am[2], fabsf(v[r][2])); am[3] = fmaxf(am[3], fabsf(v[r][3])); }
#pragma unroll
        for (int o = 8; o <= 32; o <<= 1) { am[0] = fmaxf(am[0], __shfl_xor(am[0], o)); am[1] = fmaxf(am[1], __shfl_xor(am[1], o)); am[2] = fmaxf(am[2], __shfl_xor(am[2], o)); am[3] = fmaxf(am[3], __shfl_xor(am[3], o)); }
        if (lane < 8) *(LAS f32x4*)(tile + wid * 32 + 4 * lane) = am;
        WG_SYNC();
        f32x4 amx = (f32x4){0.f, 0.f, 0.f, 0.f};
#pragma unroll
        for (int w2 = 0; w2 < 8; ++w2) { const f32x4 t = *(const LAS f32x4*)(tile + w2 * 32 + n4); amx[0] = fmaxf(amx[0], t[0]); amx[1] = fmaxf(amx[1], t[1]); amx[2] = fmaxf(amx[2], t[2]); amx[3] = fmaxf(amx[3], t[3]); }
        float inv[4];
#pragma unroll
        for (int q = 0; q < 4; ++q) inv[q] = amx[q] > 0.f ? 127.0f / amx[q] : 0.f;
        if (kg == 0) *(f32x4*)(scd + n0 + n4) = amx * (1.0f / 127.0f);
#pragma unroll
        for (int q = 0; q < 4; ++q) { unsigned wd[4];
#pragma unroll
            for (int r4 = 0; r4 < 4; ++r4) wd[r4] = pack_i8x4(v[4 * r4][q] * inv[q], v[4 * r4 + 1][q] * inv[q], v[4 * r4 + 2][q] * inv[q], v[4 * r4 + 3][q] * inv[q]);
            u32x4 o; o.x = wd[0]; o.y = wd[1]; o.z = wd[2]; o.w = wd[3];
            *(u32x4*)(dst + (size_t)(n0 + n4 + q) * 1024 + 16 * kg) = o; }
        WG_SYNC();
    }
    for (int it = 5120 + c; it < 6400; it += G) {
        if (false) {
        } else if (it < 5888) { const int q = it - 5120, ln = q / 128, r = q % 128, nt = r / 8, kt = r % 8;
            transpose_tile(tile, p.w_branch + (size_t)ln * 512 * 1024, 1024, nt * 64, kt * 64, (bf16_t*)(ws + WS_WBR) + (size_t)ln * 1024 * 512, 512, nt * 64);
        } else if (it < 6400) { const int q = it - 5888, l = q / 256, r = q % 256, nt = r / 16, kt = r % 16;
            transpose_tile(tile, p.w_out + (size_t)l * 1024 * 1024, 1024, nt * 64, kt * 64, (bf16_t*)(ws + WS_WOUT) + (size_t)l * 1024 * 1024, 1024, nt * 64);
        } else { const int q = it - 6400, l = q / 512, r = q % 512, nt = r / 16, kt = r % 16;
            transpose_tile(tile, p.peer_wq + (size_t)l * 1024 * 2048, 2048, nt * 64, kt * 64, (bf16_t*)(ws + WS_WQ) + (size_t)l * 2048 * 1024, 1024, nt * 64); }
    }
    for (int i = (c * 512 + tid) * 8; i < 2 * 8 * 2 * 128 * 128; i += G * 512 * 8) {
        const f32x4 a = *(const f32x4*)(p.peer_keys + i), b = *(const f32x4*)(p.peer_keys + i + 4);
        u32x4 w; w.x = cvt_pk_bf16(a[0], a[1]); w.y = cvt_pk_bf16(a[2], a[3]); w.z = cvt_pk_bf16(b[0], b[1]); w.w = cvt_pk_bf16(b[2], b[3]);
        *(u32x4*)((bf16_t*)(ws + WS_KEYS) + i) = w; }
    for (int row = c * 8 + wid; row < 2 * NEXP; row += G * 8) { f32x4 vr[4]; table_row_load(p, row / NEXP, 0, row % NEXP, lane, vr); table_row_store(ws, row / NEXP, 0, row % NEXP, lane, vr); }
    for (int i = c * 512 + tid; i < 32 * 132; i += G * 512) { const int hh = i / 132, ds = i % 132; const int dil = hh < 16 ? 1 : (hh < 24 ? 4 : 16); const int d = ds * dil;
        int bucket = d;
        if (d >= 16) { bucket = 16 + (int)(log((double)d / 16.0) / log(128.0) * 16.0); if (bucket > 31) bucket = 31; }
        ((float*)(ws + WS_LUT))[i] = p.rel_bias[bucket * 32 + hh]; }
    rmsnorm_phase<2>(p.x, p.norm_mix, ws + WS_H, G, c, (float*)(ws + WS_HSC));
}

struct AttnUnit { int qcol, kcol, vcol, dil, maxd, lutrow, batch, r, blk, head; float sink; float* lse; };
__device__ __forceinline__ void attn_decode(const Params& p, int layer, bool groupB, int u, AttnUnit& a) {
    if (!groupB) { a.head = u & 7; const int rest = u >> 3; a.batch = rest >> 4; a.blk = rest & 15; a.r = 0; a.dil = 1; a.maxd = 127;
        a.qcol = C_QA + 64 * a.head; a.kcol = C_KA + 64 * (a.head >> 2); a.vcol = C_VA + 64 * (a.head >> 2); a.lutrow = a.head; a.sink = p.sinks[layer * 8 + a.head]; a.lse = nullptr; }
    else { const int g = u >> 10, uu = u & 1023; a.head = uu & 7; const int rest = uu >> 3; a.batch = rest >> 4; const int sb = rest & 15; a.dil = 1 << (2 * g); const int nblk = 16 >> (2 * g);
        a.r = sb / nblk; a.blk = sb % nblk; a.maxd = 128; const int base = C_B0 + 1536 * g;
        a.qcol = base + 64 * a.head; a.kcol = base + 512 + 64 * a.head; a.vcol = base + 1024 + 64 * a.head; a.lutrow = 8 + 8 * g + a.head; a.sink = -3.0e38f; a.lse = (float*)(p.ws + WS_LSE) + (size_t)g * T_TOK * 8; }
}
__device__ __forceinline__ void attn_issue(const bf16_t* P, const float* lutg, const AttnUnit& a, int tid, int w, int j, int g4, uint4 (&kreg)[4], uint4 (&vreg)[4], uint4 (&qreg)[2], float& lutv) {
    lutv = lutg[a.lutrow * 132 + (tid < 132 ? tid : 0)];
#pragma unroll
    for (int q = 0; q < 4; ++q) { const int piece = tid + 512 * q, row = piece >> 3, seg = piece & 7; const int sub = 128 * (a.blk - 1) + row;
        if (sub >= 0) { const size_t grow = (size_t)a.batch * SEQ + (size_t)sub * a.dil + a.r; kreg[q] = *(const uint4*)(P + pidx(grow, a.kcol + 8 * seg)); vreg[q] = *(const uint4*)(P + pidx(grow, a.vcol + 8 * seg)); }
        else { kreg[q] = make_uint4(0u, 0u, 0u, 0u); vreg[q] = make_uint4(0u, 0u, 0u, 0u); } }
    const size_t qrow = (size_t)a.batch * SEQ + (size_t)(128 * a.blk + 16 * w + j) * a.dil + a.r; const bf16_t* qp = P + pidx(qrow, a.qcol + 8 * g4);
    qreg[0] = *(const uint4*)qp; qreg[1] = *(const uint4*)(qp + 32);
}
__device__ __forceinline__ bf16x8 as_bf16x8(uint4 v) { union { uint4 u; bf16x8 b; } x; x.u = v; return x.b; }
__device__ __forceinline__ bf16x8 mk_bf16x8(unsigned a, unsigned b, unsigned c, unsigned d) { union { unsigned u[4]; bf16x8 v; } x; x.u[0] = a; x.u[1] = b; x.u[2] = c; x.u[3] = d; return x.v; }

typedef short v4s_t __attribute__((ext_vector_type(4)));
__device__ __forceinline__ u32x2 lds_tr16(const LAS unsigned char* p) { return __builtin_bit_cast(u32x2, __builtin_amdgcn_ds_read_tr16_b64_v4i16((LAS v4s_t*)p)); }
__device__ __forceinline__ u32x2 lds_tr16_v(const LAS unsigned char* p) { u32x2 r; asm volatile("ds_read_b64_tr_b16 %0, %1" : "=v"(r) : "v"((unsigned)(size_t)p) : "memory"); return r; }
__device__ __forceinline__ void attn_phase(const Params& p, LAS unsigned char* L, int layer, bool groupB, int G, int c, bool dry = false) {
    const int tid = opaque_tid(), lane = tid & 63, w = __builtin_amdgcn_readfirstlane(tid >> 6), j = lane & 15, g4 = lane >> 4;
    bf16_t* P = (bf16_t*)(p.ws + WS_P);
    const float* lutg = (const float*)(p.ws + WS_LUT);
    LAS unsigned char* Ks = L; LAS unsigned char* Vs = L + 36864; LAS float* lutL = (LAS float*)(L + 36864 + 40960);
    const int nunits = groupB ? 3072 : 1024;
    int u = c; if (u >= nunits) return;
    uint4 kreg[4], vreg[4], qreg[2]; float lutv; AttnUnit cu, nu;
    attn_decode(p, layer, groupB, u, cu); attn_issue(P, lutg, cu, tid, w, j, g4, kreg, vreg, qreg, lutv);
    const int trq = (lane & 15) >> 2, trp = lane & 3;
    const float C1 = 0.125f * 1.4426950408889634f;
    for (;;) {
#pragma unroll
        for (int q = 0; q < 4; ++q) { const int piece = tid + 512 * q, row = piece >> 3, seg = piece & 7;
            *(LAS u32x4*)(Ks + row * 144 + seg * 16) = (u32x4){kreg[q].x, kreg[q].y, kreg[q].z, kreg[q].w};
            *(LAS u32x4*)(Vs + row * 160 + seg * 16) = (u32x4){vreg[q].x, vreg[q].y, vreg[q].z, vreg[q].w}; }
        if (tid < 132) lutL[tid] = lutv * 1.4426950408889634f;
        const bf16x8 qf0 = as_bf16x8(qreg[0]), qf1 = as_bf16x8(qreg[1]);
        WG_SYNC();
        const int un = u + G; const bool has_next = un < nunits;
        if (has_next) { attn_decode(p, layer, groupB, un, nu); attn_issue(P, lutg, nu, tid, w, j, g4, kreg, vreg, qreg, lutv); }
#define LDS_WAIT() __builtin_amdgcn_sched_barrier(0)
        const LAS float* lutp = lutL + (128 + j - 4 * g4);
        const int dq = j - 4 * g4;
        float biasv[9][4];
#pragma unroll
        for (int kt = 0; kt < 9; ++kt)
#pragma unroll
            for (int e = 0; e < 4; ++e) biasv[kt][e] = (kt == 8) ? lutL[(dq - e) < 0 ? 0 : (dq - e)] : lutp[-16 * kt - e];
        bf16x8 kf[2][3][2];
        const LAS unsigned char* kb0 = Ks + (16 * w + j) * 144 + 16 * g4;
#pragma unroll
        for (int t3 = 0; t3 < 3; ++t3) { kf[0][t3][0] = *(const LAS bf16x8*)(kb0 + t3 * 16 * 144); kf[0][t3][1] = *(const LAS bf16x8*)(kb0 + t3 * 16 * 144 + 64); }
        f32x4 sacc[9];
#pragma unroll
        for (int gq = 0; gq < 3; ++gq) { LDS_WAIT();
            if (gq < 2) {
#pragma unroll
                for (int t3 = 0; t3 < 3; ++t3) { kf[(gq + 1) & 1][t3][0] = *(const LAS bf16x8*)(kb0 + (3 * (gq + 1) + t3) * 16 * 144); kf[(gq + 1) & 1][t3][1] = *(const LAS bf16x8*)(kb0 + (3 * (gq + 1) + t3) * 16 * 144 + 64); } }
#pragma unroll
            for (int t3 = 0; t3 < 3; ++t3) { const int kt = 3 * gq + t3; sacc[kt] = (f32x4){0.f, 0.f, 0.f, 0.f};
                sacc[kt] = __builtin_amdgcn_mfma_f32_16x16x32_bf16(kf[gq & 1][t3][0], qf0, sacc[kt], 0, 0, 0);
                sacc[kt] = __builtin_amdgcn_mfma_f32_16x16x32_bf16(kf[gq & 1][t3][1], qf1, sacc[kt], 0, 0, 0); } }
        const float sinkl = cu.sink * 1.4426950408889634f;
        float mx = -3.0e38f;
#pragma unroll
        for (int kt = 0; kt < 9; ++kt) { const bool tile_ok = (cu.blk > 0) || (w + kt >= 8);
#pragma unroll
            for (int e = 0; e < 4; ++e) { bool valid = tile_ok;
                if (kt == 0) valid = valid && (128 + dq - e <= cu.maxd);
                if (kt == 8) valid = valid && (dq - e >= 0);
                const float sv = valid ? sacc[kt][e] * C1 + biasv[kt][e] : -1.0e30f;
                sacc[kt][e] = sv; mx = fmaxf(mx, sv); } }
        mx = fmaxf(mx, __shfl_xor(mx, 16)); mx = fmaxf(mx, __shfl_xor(mx, 32)); mx = fmaxf(mx, sinkl);
        float sum = 0.f;
#pragma unroll
        for (int kt = 0; kt < 9; ++kt)
#pragma unroll
            for (int e = 0; e < 4; ++e) { const float pv = __builtin_amdgcn_exp2f(sacc[kt][e] - mx); sacc[kt][e] = pv; sum += pv; }
        sum += __shfl_xor(sum, 16); sum += __shfl_xor(sum, 32);
        const float denom = sum + __builtin_amdgcn_exp2f(sinkl - mx);
        bf16x8 pb[5];
#pragma unroll
        for (int cc = 0; cc < 5; ++cc) { const unsigned a0 = cvt_pk_bf16(sacc[2 * cc][0], sacc[2 * cc][1]), a1 = cvt_pk_bf16(sacc[2 * cc][2], sacc[2 * cc][3]);
            unsigned b0 = 0u, b1 = 0u; if (cc < 4) { b0 = cvt_pk_bf16(sacc[2 * cc + 1][0], sacc[2 * cc + 1][1]); b1 = cvt_pk_bf16(sacc[2 * cc + 1][2], sacc[2 * cc + 1][3]); }
            pb[cc] = mk_bf16x8(a0, a1, b0, b1); }
        f32x4 oacc[4];
        const LAS unsigned char* vbase = Vs + (16 * w + 4 * g4 + trq) * 160 + 8 * trp;
        u32x2 vf[2][5][2];
#pragma unroll
        for (int cc = 0; cc < 5; ++cc) { vf[0][cc][0] = lds_tr16(vbase + (32 * cc) * 160); vf[0][cc][1] = (cc < 4) ? lds_tr16(vbase + (32 * cc + 16) * 160) : (u32x2){0u, 0u}; }
#pragma unroll
        for (int dt = 0; dt < 4; ++dt) { LDS_WAIT();
            if (dt < 3) {
#pragma unroll
                for (int cc = 0; cc < 5; ++cc) { vf[(dt + 1) & 1][cc][0] = lds_tr16(vbase + (32 * cc) * 160 + 32 * (dt + 1)); vf[(dt + 1) & 1][cc][1] = (cc < 4) ? lds_tr16(vbase + (32 * cc + 16) * 160 + 32 * (dt + 1)) : (u32x2){0u, 0u}; } }
            oacc[dt] = (f32x4){0.f, 0.f, 0.f, 0.f};
#pragma unroll
            for (int cc = 0; cc < 5; ++cc) oacc[dt] = __builtin_amdgcn_mfma_f32_16x16x32_bf16(mk_bf16x8(vf[dt & 1][cc][0].x, vf[dt & 1][cc][0].y, vf[dt & 1][cc][1].x, vf[dt & 1][cc][1].y), pb[cc], oacc[dt], 0, 0, 0); }
#undef LDS_WAIT
        const float inv = __builtin_amdgcn_rcpf(denom);
        const size_t qrow = (size_t)cu.batch * SEQ + (size_t)(128 * cu.blk + 16 * w + j) * cu.dil + cu.r;
        bf16_t* op = P + pidx(qrow, cu.qcol + 4 * g4);
#pragma unroll
        for (int dt = 0; dt < 4; ++dt) { u32x2 o; o.x = cvt_pk_bf16(oacc[dt][0] * inv, oacc[dt][1] * inv); o.y = cvt_pk_bf16(oacc[dt][2] * inv, oacc[dt][3] * inv); if (!dry) *(u32x2*)(op + 16 * dt) = o; }
        if (cu.lse != nullptr && g4 == 0 && !dry) cu.lse[qrow * 8 + cu.head] = (mx + __builtin_amdgcn_logf(denom)) * 0.6931471805599453f;
        WG_SYNC();
        if (!has_next) break;
        cu = nu; u = un;
    }
}
__device__ __forceinline__ void combine_phase(const Params& p, int G, int c, bool dry = false) {
    bf16_t* P = (bf16_t*)(p.ws + WS_P); const float* LSE = (const float*)(p.ws + WS_LSE);
    const int tid = opaque_tid();
    for (int i = c * 512 + tid; i < T_TOK * 64; i += G * 512) { const int seg = i & 7, h = (i >> 3) & 7, t = i >> 6;
        const float l0 = LSE[(size_t)t * 8 + h], l1 = LSE[(size_t)T_TOK * 8 + (size_t)t * 8 + h], l2 = LSE[(size_t)2 * T_TOK * 8 + (size_t)t * 8 + h];
        const float m = fmaxf(l0, fmaxf(l1, l2)); float w0 = fexp(l0 - m), w1 = fexp(l1 - m), w2 = fexp(l2 - m); const float inv = 1.0f / (w0 + w1 + w2); w0 *= inv; w1 *= inv; w2 *= inv;
        bf16_t* b = P + pidx((size_t)t, C_B0 + 64 * h + 8 * seg);
        const u32x4 a0 = *(const u32x4*)b, a1 = *(const u32x4*)(P + pidx((size_t)t, C_B0 + 1536 + 64 * h + 8 * seg)), a2 = *(const u32x4*)(P + pidx((size_t)t, C_B0 + 3072 + 64 * h + 8 * seg));
        u32x4 o;
        o.x = cvt_pk_bf16(w0 * bflo(a0.x) + w1 * bflo(a1.x) + w2 * bflo(a2.x), w0 * bfhi(a0.x) + w1 * bfhi(a1.x) + w2 * bfhi(a2.x));
        o.y = cvt_pk_bf16(w0 * bflo(a0.y) + w1 * bflo(a1.y) + w2 * bflo(a2.y), w0 * bfhi(a0.y) + w1 * bfhi(a1.y) + w2 * bfhi(a2.y));
        o.z = cvt_pk_bf16(w0 * bflo(a0.z) + w1 * bflo(a1.z) + w2 * bflo(a2.z), w0 * bfhi(a0.z) + w1 * bfhi(a1.z) + w2 * bfhi(a2.z));
        o.w = cvt_pk_bf16(w0 * bflo(a0.w) + w1 * bflo(a1.w) + w2 * bflo(a2.w), w0 * bfhi(a0.w) + w1 * bfhi(a1.w) + w2 * bfhi(a2.w));
        if (!dry) *(u32x4*)b = o; }
}

__device__ __forceinline__ void gla_cum(const LAS unsigned char* LA, int c, int s, LAS float* tot, float (&cum)[8], float& last) {
    float run = 0.f;
#pragma unroll
    for (int jr = 0; jr < 8; ++jr) { run += bf2f(*(const LAS unsigned short*)(LA + (8 * s + jr) * 128 + 2 * c)); cum[jr] = run; }
    tot[s * 64 + c] = run;
    WG_SYNC();
    float off = 0.f, all = 0.f;
#pragma unroll
    for (int s2 = 0; s2 < 8; ++s2) { const float v = tot[s2 * 64 + c]; all += v; off += (s2 < s) ? v : 0.f; }
#pragma unroll
    for (int jr = 0; jr < 8; ++jr) cum[jr] += off;
    last = all;
}
__device__ __forceinline__ u32x4 to_u32x4(uint4 v) { return (u32x4){v.x, v.y, v.z, v.w}; }
__device__ __forceinline__ void gla_a_phase(const Params& p, LAS unsigned char* L, int G, int c) {
    const int tid = opaque_tid(), lane = tid & 63, w = __builtin_amdgcn_readfirstlane(tid >> 6), j = lane & 15, g4 = lane >> 4, cc = tid & 63, s = tid >> 6;
    const int trq = (lane & 15) >> 2, trp = lane & 3;
    const bf16_t* P = (const bf16_t*)(p.ws + WS_P); float* KV = (float*)(p.ws + WS_H); float* DEC = (float*)(p.ws + WS_DECAY);
    LAS unsigned char* LA = L; LAS unsigned char* KT = L + 8192; LAS unsigned char* VS = L + 16384; LAS unsigned char* KeT = L + 34816; LAS float* tot = (LAS float*)(L + 44032);
    int u = c; if (u >= 1024) return;
    uint4 rla, rk, rv[2];
#define GLA_A_ISSUE(uu) do { const int h_ = (uu) & 3, n_ = ((uu) >> 2) & 31, b_ = (uu) >> 7; const size_t tr_ = (size_t)b_ * SEQ + 64 * n_; \
        rla = *(const uint4*)(P + pidx(tr_ + (tid >> 3), C_Z + 64 * h_ + 8 * (tid & 7))); rk = *(const uint4*)(P + pidx(tr_ + (tid >> 3), C_KC + 64 * h_ + 8 * (tid & 7))); \
        _Pragma("unroll") for (int q_ = 0; q_ < 2; ++q_) { const int pc_ = tid + 512 * q_; rv[q_] = *(const uint4*)(P + pidx(tr_ + (pc_ >> 4), C_VC + 128 * h_ + 8 * (pc_ & 15))); } } while (0)
    GLA_A_ISSUE(u);
    for (;;) { const int h = u & 3, n = (u >> 2) & 31, b = u >> 7; const int base = (b * 32 + n) * 4 + h;
        *(LAS u32x4*)(LA + (tid >> 3) * 128 + (tid & 7) * 16) = to_u32x4(rla); *(LAS u32x4*)(KT + (tid >> 3) * 128 + (tid & 7) * 16) = to_u32x4(rk);
#pragma unroll
        for (int q = 0; q < 2; ++q) { const int pc = tid + 512 * q; *(LAS u32x4*)(VS + (pc >> 4) * 288 + (pc & 15) * 16) = to_u32x4(rv[q]); }
        WG_SYNC();
        const int un = u + G; const bool has_next = un < 1024;
        if (has_next) GLA_A_ISSUE(un);
        float cum[8], last; gla_cum(LA, cc, s, tot, cum, last);
        float ke[8];
#pragma unroll
        for (int jr = 0; jr < 8; ++jr) ke[jr] = bf2f(*(const LAS unsigned short*)(KT + (8 * s + jr) * 128 + 2 * cc)) * fexp(last - cum[jr]);
        u32x4 kw; kw.x = cvt_pk_bf16(ke[0], ke[1]); kw.y = cvt_pk_bf16(ke[2], ke[3]); kw.z = cvt_pk_bf16(ke[4], ke[5]); kw.w = cvt_pk_bf16(ke[6], ke[7]);
        *(LAS u32x4*)(KeT + cc * 144 + 16 * s) = kw;
        if (s == 0) DEC[base * 64 + cc] = fexp(last);
        WG_SYNC();
        f32x4 acc[4];
#pragma unroll
        for (int ct = 0; ct < 4; ++ct) acc[ct] = (f32x4){0.f, 0.f, 0.f, 0.f};
#pragma unroll
        for (int k2 = 0; k2 < 2; ++k2) { const LAS unsigned char* vb = VS + (32 * k2 + 8 * g4 + trq) * 288 + (16 * w + 4 * trp) * 2;
            const u32x2 lo = lds_tr16(vb), hi = lds_tr16(vb + 4 * 288); const bf16x8 af = mk_bf16x8(lo.x, lo.y, hi.x, hi.y);
#pragma unroll
            for (int ct = 0; ct < 4; ++ct) acc[ct] = __builtin_amdgcn_mfma_f32_16x16x32_bf16(af, *(const LAS bf16x8*)(KeT + (16 * ct + j) * 144 + (8 * g4 + 32 * k2) * 2), acc[ct], 0, 0, 0); }
#pragma unroll
        for (int ct = 0; ct < 4; ++ct)
#pragma unroll
            for (int e = 0; e < 4; ++e) KV[((size_t)base * 128 + 16 * w + 4 * g4 + e) * 64 + 16 * ct + j] = acc[ct][e];
        WG_SYNC();
        if (!has_next) break;
        u = un;
    }
#undef GLA_A_ISSUE
}
__device__ __forceinline__ void gla_scan_phase(const Params& p, int G, int c) {
    const float* KV = (const float*)(p.ws + WS_H); const float* DEC = (const float*)(p.ws + WS_DECAY); bf16_t* SP = (bf16_t*)(p.ws + WS_SPREV);
    const int tid = opaque_tid();
    for (int eid = c * 512 + tid; eid < 262144; eid += G * 512) { const int cc = eid & 63, v = (eid >> 6) & 127, h = (eid >> 13) & 3, b = eid >> 15;
        float state = 0.f;
        for (int n0 = 0; n0 < 32; n0 += 8) {
            float kvv[8], dcv[8];
#pragma unroll
            for (int q = 0; q < 8; ++q) { const int base = (b * 32 + n0 + q) * 4 + h; kvv[q] = KV[((size_t)base * 128 + v) * 64 + cc]; dcv[q] = DEC[base * 64 + cc]; }
#pragma unroll
            for (int q = 0; q < 8; ++q) { const int base = (b * 32 + n0 + q) * 4 + h; SP[((size_t)base * 128 + v) * 64 + cc] = (bf16_t)(cvt_pk_bf16(state, 0.f) & 0xffffu); state = state * dcv[q] + kvv[q]; } } }
}
__device__ __forceinline__ void gla_c_phase(const Params& p, LAS unsigned char* L, int layer, int G, int c, bool dry = false) {
    const int tid = opaque_tid(), lane = tid & 63, w = __builtin_amdgcn_readfirstlane(tid >> 6), j = lane & 15, g4 = lane >> 4, cc = tid & 63, s = tid >> 6;
    const int trq = (lane & 15) >> 2, trp = lane & 3;
    bf16_t* P = (bf16_t*)(p.ws + WS_P); const bf16_t* SP = (const bf16_t*)(p.ws + WS_SPREV);
    LAS unsigned char* LA = L; LAS unsigned char* KT = L + 8192; LAS unsigned char* QT = L + 16384; LAS unsigned char* VS = L + 24576;
    LAS unsigned char* QD = L + 43008; LAS unsigned char* KI = L + 52224; LAS float* tot = (LAS float*)(L + 61440); LAS float* ssb = (LAS float*)(L + 63488);
    const int tt = w & 3, vh = w >> 2;
    int u = c; if (u >= 1024) return;
    f32x4 hnv[4];
#pragma unroll
    for (int vt = 0; vt < 4; ++vt) hnv[vt] = *(const f32x4*)(p.head_norm + layer * 128 + 16 * (4 * vh + vt) + 4 * g4);
    uint4 rla, rk, rq, rv[2];
#define GLA_C_ISSUE(uu) do { const int h_ = (uu) & 3, n_ = ((uu) >> 2) & 31, b_ = (uu) >> 7; const size_t tr_ = (size_t)b_ * SEQ + 64 * n_; \
        rla = *(const uint4*)(P + pidx(tr_ + (tid >> 3), C_Z + 64 * h_ + 8 * (tid & 7))); rk = *(const uint4*)(P + pidx(tr_ + (tid >> 3), C_KC + 64 * h_ + 8 * (tid & 7))); rq = *(const uint4*)(P + pidx(tr_ + (tid >> 3), C_QC + 64 * h_ + 8 * (tid & 7))); \
        _Pragma("unroll") for (int q_ = 0; q_ < 2; ++q_) { const int pc_ = tid + 512 * q_; rv[q_] = *(const uint4*)(P + pidx(tr_ + (pc_ >> 4), C_VC + 128 * h_ + 8 * (pc_ & 15))); } } while (0)
    GLA_C_ISSUE(u);
    for (;;) { const int h = u & 3, n = (u >> 2) & 31, b = u >> 7; const size_t trow0 = (size_t)b * SEQ + 64 * n; const int base = (b * 32 + n) * 4 + h;
        *(LAS u32x4*)(LA + (tid >> 3) * 128 + (tid & 7) * 16) = to_u32x4(rla); *(LAS u32x4*)(KT + (tid >> 3) * 128 + (tid & 7) * 16) = to_u32x4(rk); *(LAS u32x4*)(QT + (tid >> 3) * 128 + (tid & 7) * 16) = to_u32x4(rq);
#pragma unroll
        for (int q = 0; q < 2; ++q) { const int pc = tid + 512 * q; *(LAS u32x4*)(VS + (pc >> 4) * 288 + (pc & 15) * 16) = to_u32x4(rv[q]); }
        WG_SYNC();
        bf16x8 spf[4][2]; u32x2 rr[4]; const size_t orw = trow0 + 16 * tt + j;
#pragma unroll
        for (int vt = 0; vt < 4; ++vt) { const int V = 4 * vh + vt;
#pragma unroll
            for (int k2 = 0; k2 < 2; ++k2) spf[vt][k2] = *(const bf16x8*)(SP + ((size_t)base * 128 + 16 * V + j) * 64 + 8 * g4 + 32 * k2);
            rr[vt] = *(const u32x2*)(P + pidx(orw, C_RC + 128 * h + 16 * V + 4 * g4)); }
        const int un = u + G; const bool has_next = un < 1024;
        if (has_next) GLA_C_ISSUE(un);
        float cum[8], last; gla_cum(LA, cc, s, tot, cum, last);
#pragma unroll
        for (int jr = 0; jr < 8; ++jr) { const int ro = (8 * s + jr) * 128 + 2 * cc;
            const float qd = bf2f(*(const LAS unsigned short*)(QT + ro)) * 0.125f * fexp(cum[jr]), ki = bf2f(*(const LAS unsigned short*)(KT + ro)) * fexp(-cum[jr]);
            *(LAS unsigned short*)(QD + (8 * s + jr) * 144 + 2 * cc) = (unsigned short)(cvt_pk_bf16(qd, 0.f) & 0xffffu);
            *(LAS unsigned short*)(KI + (8 * s + jr) * 144 + 2 * cc) = (unsigned short)(cvt_pk_bf16(ki, 0.f) & 0xffffu); }
        WG_SYNC();
        bf16x8 qdf[2];
#pragma unroll
        for (int k2 = 0; k2 < 2; ++k2) qdf[k2] = *(const LAS bf16x8*)(QD + (16 * tt + j) * 144 + (8 * g4 + 32 * k2) * 2);
        f32x4 sa[4];
#pragma unroll
        for (int st = 0; st < 4; ++st) { sa[st] = (f32x4){0.f, 0.f, 0.f, 0.f};
            if (st <= tt) {
#pragma unroll
                for (int k2 = 0; k2 < 2; ++k2) sa[st] = __builtin_amdgcn_mfma_f32_16x16x32_bf16(*(const LAS bf16x8*)(KI + (16 * st + j) * 144 + (8 * g4 + 32 * k2) * 2), qdf[k2], sa[st], 0, 0, 0);
                if (st == tt) {
#pragma unroll
                    for (int e = 0; e < 4; ++e) if (4 * g4 + e > j) sa[st][e] = 0.f; } } }
        bf16x8 pb[2];
#pragma unroll
        for (int c2 = 0; c2 < 2; ++c2) pb[c2] = mk_bf16x8(cvt_pk_bf16(sa[2 * c2][0], sa[2 * c2][1]), cvt_pk_bf16(sa[2 * c2][2], sa[2 * c2][3]), cvt_pk_bf16(sa[2 * c2 + 1][0], sa[2 * c2 + 1][1]), cvt_pk_bf16(sa[2 * c2 + 1][2], sa[2 * c2 + 1][3]));
        f32x4 oacc[4]; float ss = 0.f;
#pragma unroll
        for (int vt = 0; vt < 4; ++vt) { const int V = 4 * vh + vt; oacc[vt] = (f32x4){0.f, 0.f, 0.f, 0.f};
#pragma unroll
            for (int c2 = 0; c2 < 2; ++c2) { const LAS unsigned char* vb = VS + (32 * c2 + 4 * g4 + trq) * 288 + (16 * V + 4 * trp) * 2; const u32x2 lo = lds_tr16(vb), hi = lds_tr16(vb + 16 * 288);
                oacc[vt] = __builtin_amdgcn_mfma_f32_16x16x32_bf16(mk_bf16x8(lo.x, lo.y, hi.x, hi.y), pb[c2], oacc[vt], 0, 0, 0); }
#pragma unroll
            for (int k2 = 0; k2 < 2; ++k2) oacc[vt] = __builtin_amdgcn_mfma_f32_16x16x32_bf16(spf[vt][k2], qdf[k2], oacc[vt], 0, 0, 0);
            ss += oacc[vt][0] * oacc[vt][0] + oacc[vt][1] * oacc[vt][1] + oacc[vt][2] * oacc[vt][2] + oacc[vt][3] * oacc[vt][3]; }
        ss += __shfl_xor(ss, 16); ss += __shfl_xor(ss, 32);
        if (g4 == 0) ssb[vh * 64 + 16 * tt + j] = ss;
        WG_SYNC();
        const float rstd = __builtin_amdgcn_rsqf((ssb[16 * tt + j] + ssb[64 + 16 * tt + j]) * (1.0f / 128.0f) + 1e-6f);
#pragma unroll
        for (int vt = 0; vt < 4; ++vt) { const int v0 = 16 * (4 * vh + vt) + 4 * g4; const f32x4 hn = hnv[vt];
            const float r0 = bflo(rr[vt].x), r1 = bfhi(rr[vt].x), r2 = bflo(rr[vt].y), r3 = bfhi(rr[vt].y);
            u32x2 o; o.x = cvt_pk_bf16(oacc[vt][0] * rstd * hn[0] * r0 * fsigmoid(r0), oacc[vt][1] * rstd * hn[1] * r1 * fsigmoid(r1));
            o.y = cvt_pk_bf16(oacc[vt][2] * rstd * hn[2] * r2 * fsigmoid(r2), oacc[vt][3] * rstd * hn[3] * r3 * fsigmoid(r3));
            if (!dry) *(u32x2*)(P + pidx(orw, C_VC + 128 * h + v0)) = o; }
        WG_SYNC();
        if (!has_next) break;
        u = un;
    }
#undef GLA_C_ISSUE
}

__device__ __forceinline__ int sort_key(float f) { const int u = __float_as_int(f); return u ^ ((u >> 31) & 0x7fffffff); }
__device__ __forceinline__ int med3i(int a, int b, int c) { return max(min(a, b), min(max(a, b), c)); }
__device__ __forceinline__ void topk_insert(int (&v)[16], int x) {
#pragma unroll
    for (int i = 15; i >= 1; --i) v[i] = med3i(v[i - 1], x, v[i]);
    v[0] = max(v[0], x);
}
__device__ __forceinline__ float key_val(int k, int mask) { const int kk = k & ~mask; return __int_as_float(kk ^ ((kk >> 31) & 0x7fffffff)); }
__device__ __forceinline__ void topk_merge16(int (&v)[16], int xm) {
    int t[16];
#pragma unroll
    for (int i = 0; i < 16; ++i) t[i] = max(v[i], __shfl_xor(v[15 - i], xm));
#pragma unroll
    for (int s = 8; s >= 1; s >>= 1)
#pragma unroll
        for (int i = 0; i < 16; ++i) if ((i & s) == 0) { const int hi = max(t[i], t[i + s]), lo = min(t[i], t[i + s]); t[i] = hi; t[i + s] = lo; }
#pragma unroll
    for (int i = 0; i < 16; ++i) v[i] = t[i];
}
__device__ __forceinline__ void peer_topk_phase(const Params& p, LAS unsigned char* L, int layer, int G, int c) {
    const int tid = opaque_tid(), lane = tid & 63, w = __builtin_amdgcn_readfirstlane(tid >> 6), j = lane & 15, g4 = lane >> 4;
    const bf16_t* QY = (const bf16_t*)(p.ws + WS_QY); const bf16_t* KEYS = (const bf16_t*)(p.ws + WS_KEYS); unsigned* IDXW = (unsigned*)(p.ws + WS_IDX); float* GATE = (float*)(p.ws + WS_GATE);
    LAS unsigned char* KL = L; LAS int* TK = (LAS int*)(L + 69632) + (w * 16 + j) * 32;
    int cur_h = -1;
    for (int u = c; u < 1024; u += G) { const int h = u & 7, tb = u >> 3;
        if (h != cur_h) { WG_SYNC();
#pragma unroll
            for (int q = 0; q < 8; ++q) { const int piece = tid + 512 * q, row = piece >> 4, seg = piece & 15;
                *(LAS u32x4*)(KL + row * 272 + seg * 16) = *(const u32x4*)(KEYS + ((size_t)(layer * 8 + h) * 256 + row) * 128 + 8 * seg); }
            WG_SYNC(); cur_h = h; }
        const size_t tok = (size_t)128 * tb + 16 * w + j;
        f32x4 tvb[2][4];
        if (layer == 0) {
#pragma unroll
            for (int b = 0; b < 2; ++b) { const int r = 4 * (u * 8 + w) + b; table_row_load(p, r / NEXP, 1, r % NEXP, lane, tvb[b]); } }
        int K1[16], K2[16];
#pragma unroll
        for (int pp = 0; pp < 2; ++pp) {
            bf16x8 bq[4];
#pragma unroll
            for (int kc = 0; kc < 4; ++kc) bq[kc] = *(const bf16x8*)(QY + tok * 2048 + h * 256 + pp * 128 + 8 * g4 + 32 * kc);
            int v[16];
#pragma unroll
            for (int i = 0; i < 16; ++i) v[i] = (int)0x80000000;
#pragma unroll
            for (int nt = 0; nt < 8; ++nt) { f32x4 acc = (f32x4){0.f, 0.f, 0.f, 0.f};
#pragma unroll
                for (int kc = 0; kc < 4; ++kc) acc = __builtin_amdgcn_mfma_f32_16x16x32_bf16(*(const LAS bf16x8*)(KL + (pp * 128 + 16 * nt + j) * 272 + (8 * g4 + 32 * kc) * 2), bq[kc], acc, 0, 0, 0);
#pragma unroll
                for (int e = 0; e < 4; ++e) topk_insert(v, (sort_key(acc[e]) & ~127) | (127 - (16 * nt + 4 * g4 + e))); }
            topk_merge16(v, 16); topk_merge16(v, 32);
#pragma unroll
            for (int i = 0; i < 16; ++i) { if (pp == 0) K1[i] = v[i]; else K2[i] = v[i]; }
        }
        if (layer == 0) {
#pragma unroll
            for (int b = 0; b < 2; ++b) { const int r = 4 * (u * 8 + w) + b; table_row_store(p.ws, r / NEXP, 1, r % NEXP, lane, tvb[b]); }
#pragma unroll
            for (int b = 0; b < 2; ++b) { const int r = 4 * (u * 8 + w) + 2 + b; table_row_load(p, r / NEXP, 1, r % NEXP, lane, tvb[b]); } }
        float s1[16], s2[16];
#pragma unroll
        for (int a = 0; a < 16; ++a) { s1[a] = key_val(K1[a], 127); s2[a] = key_val(K2[a], 127); }
        int v2[16];
#pragma unroll
        for (int i = 0; i < 16; ++i) v2[i] = (int)0x80000000;
#pragma unroll
        for (int a = 0; a < 16; ++a)
#pragma unroll
            for (int b = 0; b < 16; ++b) if ((a + 1) * (b + 1) <= 16) topk_insert(v2, (sort_key(s1[a] + s2[b]) & ~255) | (255 - (16 * a + b)));
        if (g4 == 0) {
#pragma unroll
            for (int i = 0; i < 16; ++i) { TK[i] = K1[i]; TK[16 + i] = K2[i]; } }
        __builtin_amdgcn_fence(__ATOMIC_RELEASE, "wavefront"); __builtin_amdgcn_wave_barrier(); __builtin_amdgcn_fence(__ATOMIC_ACQUIRE, "wavefront");
        float ts[16]; int ex[16]; float mx = -3.0e38f;
#pragma unroll
        for (int k = 0; k < 16; ++k) { const int pos = 255 - (v2[k] & 255), a = pos >> 4, b = pos & 15; const int ka = TK[a], kb = TK[16 + b];
            ts[k] = key_val(ka, 127) + key_val(kb, 127); ex[k] = (127 - (ka & 127)) * 128 + (127 - (kb & 127)); mx = fmaxf(mx, ts[k]); }
        float sum = 0.f;
#pragma unroll
        for (int k = 0; k < 16; ++k) { ts[k] = fexp(ts[k] - mx); sum += ts[k]; }
        const float inv = 1.0f / sum; const size_t o = (tok * 8 + h) * 16;
        if (g4 == 0) {
#pragma unroll
            for (int k = 0; k < 16; k += 4) { *(u32x2*)(IDXW + (o + k) / 2) = (u32x2){(unsigned)ex[k] | ((unsigned)ex[k + 1] << 16), (unsigned)ex[k + 2] | ((unsigned)ex[k + 3] << 16)}; *(f32x4*)(GATE + o + k) = (f32x4){ts[k] * inv, ts[k + 1] * inv, ts[k + 2] * inv, ts[k + 3] * inv}; } }
        __builtin_amdgcn_wave_barrier();
        if (layer == 0) {
#pragma unroll
            for (int b = 0; b < 2; ++b) { const int r = 4 * (u * 8 + w) + 2 + b; table_row_store(p.ws, r / NEXP, 1, r % NEXP, lane, tvb[b]); } }
    }
    WG_SYNC();
}

template <int CTRL> __device__ __forceinline__ float dpp_f(float v) { return __builtin_bit_cast(float, __builtin_amdgcn_update_dpp(0, __builtin_bit_cast(int, v), CTRL, 0xF, 0xF, true)); }
struct PItem { int js, t; bool valid; };
__device__ __forceinline__ PItem peer_item(int k, int c, int G, int w) { int it = c + k * G; PItem r; r.valid = it < 8 * 2048; if (!r.valid) it = c; r.js = it & 7; r.t = (it >> 3) * 8 + w; return r; }
__device__ __forceinline__ f32x2 cvt8(unsigned w, bool hi) { return hi ? __builtin_amdgcn_cvt_pk_f32_fp8((int)w, true) : __builtin_amdgcn_cvt_pk_f32_fp8((int)w, false); }

template <int CTRL> __device__ __forceinline__ int dpp_i(int v) { return __builtin_amdgcn_update_dpp(0, v, CTRL, 0xF, 0xF, true); }
__device__ __forceinline__ void pu_rows(const unsigned char* U8L, const unsigned char* XQ, const PItem& I, int sub, int grp, unsigned epk, uint4 (&d)[16], uint4& x0) {
    const unsigned char* base = U8L + (size_t)I.js * NEXP * 128;
#pragma unroll
    for (int i = 0; i < 16; ++i) { const unsigned e = ((unsigned)__shfl((int)epk, 8 * (i >> 1) + grp) >> (16 * (i & 1))) & 0xffffu; d[i] = *(const uint4*)(base + (size_t)e * 128); }
    x0 = *(const uint4*)(XQ + (size_t)I.t * DM + 128 * I.js + 16 * sub);
}
__device__ __forceinline__ void pu_compute(const uint4 (&d)[16], const uint4 x0, float* HIDP, const PItem& I, int sub, int grp) {
    int s[16];
#pragma unroll
    for (int i = 0; i < 16; ++i) { int a = __builtin_amdgcn_sdot4((int)d[i].x, (int)x0.x, 0, false); a = __builtin_amdgcn_sdot4((int)d[i].y, (int)x0.y, a, false);
        a = __builtin_amdgcn_sdot4((int)d[i].z, (int)x0.z, a, false); s[i] = __builtin_amdgcn_sdot4((int)d[i].w, (int)x0.w, a, false); }
    const bool b2 = (sub & 4) != 0, b1 = (sub & 2) != 0, b0 = (sub & 1) != 0;
    int r[8], q4[4], f[2];
#pragma unroll
    for (int k = 0; k < 8; ++k) { const int keep = b2 ? s[8 + k] : s[k], send = b2 ? s[k] : s[8 + k]; r[k] = keep + dpp_i<0x141>(send); }
#pragma unroll
    for (int k = 0; k < 4; ++k) { const int keep = b1 ? r[4 + k] : r[k], send = b1 ? r[k] : r[4 + k]; q4[k] = keep + dpp_i<0x4E>(send); }
#pragma unroll
    for (int k = 0; k < 2; ++k) { const int keep = b0 ? q4[2 + k] : q4[k], send = b0 ? q4[k] : q4[2 + k]; f[k] = keep + dpp_i<0xB1>(send); }
    if (I.valid) *(unsigned*)((bf16_t*)HIDP + (size_t)I.js * T_TOK * 128 + (size_t)I.t * 128 + 16 * sub + 2 * grp) = cvt_pk_bf16((float)f[0], (float)f[1]);
}
__device__ __forceinline__ void peer_u_phase(const Params& p, int layer, int G, int c) {
    const int tid = opaque_tid(), lane = tid & 63, w = tid >> 6, sub = lane & 7, grp = lane >> 3;
    const unsigned char* XQ = p.ws + WS_XQ; const unsigned* IDXW = (const unsigned*)(p.ws + WS_IDX); float* HIDP = (float*)(p.ws + WS_HIDP);
    const unsigned char* U8L = p.ws + WS_U8 + (size_t)layer * 8 * NEXP * 128 + 16 * sub;
    const int nit = (8 * 2048 - c + G - 1) / G;
    uint4 dA[16], dB[16], xa0, xb0; unsigned ea, eb;
    PItem IA = peer_item(0, c, G, w), IB = peer_item(1, c, G, w), IC = peer_item(2, c, G, w), ID = peer_item(3, c, G, w);
    ea = IDXW[IA.t * 64 + lane]; eb = IDXW[IB.t * 64 + lane];
    pu_rows(U8L, XQ, IA, sub, grp, ea, dA, xa0); ea = IDXW[IC.t * 64 + lane];
    pu_rows(U8L, XQ, IB, sub, grp, eb, dB, xb0); eb = IDXW[ID.t * 64 + lane];
    for (int k = 0; k < nit; k += 2) {
        pu_compute(dA, xa0, HIDP, IA, sub, grp);
        pu_rows(U8L, XQ, IC, sub, grp, ea, dA, xa0); IA = IC; IC = peer_item(k + 4, c, G, w); ea = IDXW[IC.t * 64 + lane];
        pu_compute(dB, xb0, HIDP, IB, sub, grp);
        pu_rows(U8L, XQ, ID, sub, grp, eb, dB, xb0); IB = ID; ID = peer_item(k + 5, c, G, w); eb = IDXW[ID.t * 64 + lane];
    }
}
__device__ __forceinline__ void peer_w_phase(const Params& p, int layer, int G, int c) {
    const int tid = opaque_tid();
    const unsigned* IDXW = (const unsigned*)(p.ws + WS_IDX); const float* GATE = (const float*)(p.ws + WS_GATE); const float* HIDP = (const float*)(p.ws + WS_HIDP);
    const float* USC = (const float*)(p.ws + WS_USC) + layer * NEXP; const float* VSC = (const float*)(p.ws + WS_VSC) + layer * NEXP; unsigned* EW = (unsigned*)(p.ws + WS_EW); const float* XSC = (const float*)(p.ws + WS_XSC);
    for (int i = (c * 512 + tid) * 4; i < T_TOK * 128; i += G * 512 * 4) { const u32x2 e2 = *(const u32x2*)(IDXW + i / 2); const f32x4 g = *(const f32x4*)(GATE + i); f32x4 h = (f32x4){0.f, 0.f, 0.f, 0.f};
#pragma unroll
        for (int j = 0; j < 8; ++j) { const u32x2 hb = *(const u32x2*)((const bf16_t*)HIDP + (size_t)j * T_TOK * 128 + i); h += (f32x4){bflo(hb.x), bfhi(hb.x), bflo(hb.y), bfhi(hb.y)}; }
        const int ev[4] = {(int)(e2.x & 0xffffu), (int)(e2.x >> 16), (int)(e2.y & 0xffffu), (int)(e2.y >> 16)}; unsigned ow[4]; const float xs = XSC[i >> 7];
#pragma unroll
        for (int q = 0; q < 4; ++q) ow[q] = ((unsigned)ev[q] << 16) | (cvt_pk_bf16(g[q] * fgelu_tanh(h[q] * (USC[ev[q]] * xs)) * VSC[ev[q]], 0.f) & 0xffffu);
        *(u32x4*)(EW + i) = (u32x4){ow[0], ow[1], ow[2], ow[3]}; }
}
__device__ __forceinline__ void pv_rows(const unsigned char* V8L, const float* xsrc, const PItem& I, int sub, int grp, int qoff, const unsigned ew0, const unsigned ew1, uint4 (&d)[16], unsigned (&wp)[16], f32x2& xr) {
    const unsigned char* base = V8L + (size_t)I.js * NEXP * 128;
#pragma unroll
    for (int i = 0; i < 16; ++i) { const unsigned pk = (unsigned)__shfl((int)(i < 8 ? ew0 : ew1), (8 * i + grp) & 63); wp[i] = pk; d[i] = *(const uint4*)(base + (size_t)(pk >> 16) * 128); }
    xr = *(const f32x2*)(xsrc + (size_t)I.t * DM + 128 * I.js + 16 * sub + qoff);
}
__device__ __forceinline__ void pv_compute(const uint4 (&d)[16], const unsigned (&wp)[16], const f32x2 xr, float* out, const PItem& I, int sub, int grp, int qoff, bool dryv) {
    f32x2 acc[8];
#pragma unroll
    for (int m = 0; m < 8; ++m) acc[m] = (f32x2){0.f, 0.f};
#pragma unroll
    for (int i = 0; i < 16; ++i) { const float wv = __uint_as_float(wp[i] << 16); const unsigned wq[4] = {d[i].x, d[i].y, d[i].z, d[i].w}; const f32x2 w2 = (f32x2){wv, wv};
#pragma unroll
        for (int q = 0; q < 4; ++q) { acc[2 * q] += w2 * cvt8(wq[q], false); acc[2 * q + 1] += w2 * cvt8(wq[q], true); } }
    float a[16];
#pragma unroll
    for (int m = 0; m < 8; ++m) { a[2 * m] = acc[m].x; a[2 * m + 1] = acc[m].y; }
    const bool b3 = (grp & 1) != 0, b4 = (grp & 2) != 0, b5 = (grp & 4) != 0;
    float r[8], q4[4], f[2];
#pragma unroll
    for (int k = 0; k < 8; ++k) { const float keep = b3 ? a[8 + k] : a[k], send = b3 ? a[k] : a[8 + k]; r[k] = keep + dpp_f<0x128>(send); }
#pragma unroll
    for (int k = 0; k < 4; ++k) { const float keep = b4 ? r[4 + k] : r[k], send = b4 ? r[k] : r[4 + k]; q4[k] = keep + __shfl_xor(send, 16); }
#pragma unroll
    for (int k = 0; k < 2; ++k) { const float keep = b5 ? q4[2 + k] : q4[k], send = b5 ? q4[k] : q4[2 + k]; f[k] = keep + __shfl_xor(send, 32); }
    if (I.valid && !dryv) *(f32x2*)(out + (size_t)I.t * DM + 128 * I.js + 16 * sub + qoff) = xr + (f32x2){f[0], f[1]};
}
__device__ __forceinline__ void peer_v_phase(const Params& p, int layer, const float* xsrc, int G, int c, bool dryv = false) {
    const int tid = opaque_tid(), lane = tid & 63, w = tid >> 6, sub = lane & 7, grp = lane >> 3;
    const unsigned char* V8L = p.ws + WS_V8 + (size_t)layer * 8 * NEXP * 128 + 16 * sub;
    const int qoff = 8 * (grp & 1) + 4 * ((grp >> 1) & 1) + 2 * (grp >> 2);
    const int nit = (8 * 2048 - c + G - 1) / G;
    uint4 dA[16], dB[16]; unsigned ea0, ea1, eb0, eb1, wpA[16], wpB[16]; f32x2 xra, xrb;
    const unsigned* EWu = (const unsigned*)(p.ws + WS_EW);
    PItem IA = peer_item(0, c, G, w), IB = peer_item(1, c, G, w), IC = peer_item(2, c, G, w), ID = peer_item(3, c, G, w);
    ea0 = EWu[IA.t * 128 + lane]; ea1 = EWu[IA.t * 128 + 64 + lane]; eb0 = EWu[IB.t * 128 + lane]; eb1 = EWu[IB.t * 128 + 64 + lane];
    pv_rows(V8L, xsrc, IA, sub, grp, qoff, ea0, ea1, dA, wpA, xra); ea0 = EWu[IC.t * 128 + lane]; ea1 = EWu[IC.t * 128 + 64 + lane];
    pv_rows(V8L, xsrc, IB, sub, grp, qoff, eb0, eb1, dB, wpB, xrb); eb0 = EWu[ID.t * 128 + lane]; eb1 = EWu[ID.t * 128 + 64 + lane];
    for (int k = 0; k < nit; k += 2) {
        pv_compute(dA, wpA, xra, p.out, IA, sub, grp, qoff, dryv);
        pv_rows(V8L, xsrc, IC, sub, grp, qoff, ea0, ea1, dA, wpA, xra); IA = IC; IC = peer_item(k + 4, c, G, w); ea0 = EWu[IC.t * 128 + lane]; ea1 = EWu[IC.t * 128 + 64 + lane];
        pv_compute(dB, wpB, xrb, p.out, IB, sub, grp, qoff, dryv);
        pv_rows(V8L, xsrc, ID, sub, grp, qoff, eb0, eb1, dB, wpB, xrb); IB = ID; ID = peer_item(k + 5, c, G, w); eb0 = EWu[ID.t * 128 + lane]; eb1 = EWu[ID.t * 128 + 64 + lane];
    }
}

#ifndef MK_PER_PHASE
#define MK_PER_PHASE 0
#endif
constexpr int PPL = 13;
constexpr int N_PHASES = 1 + PPL * NLAYER;

__global__ void __launch_bounds__(512, 2) mega_fwd(Params p) {
    extern __shared__ __attribute__((aligned(16))) unsigned char lds_raw[];
    LAS unsigned char* L = (LAS unsigned char*)lds_raw;
    const int G = (int)gridDim.x, c = (int)blockIdx.x;
    volatile LAS unsigned* st = (volatile LAS unsigned*)(L + LDS_MISC);
    if (threadIdx.x < 4) st[threadIdx.x] = 0u;
    __syncthreads();
    const int lo = p.ph_lo, hi = p.ph_hi;
    XcdBarrier bar; bar.bar = (unsigned*)(p.ws + WS_CTL); bar.x = 0; bar.st = st;
    if (hi - lo > 1) bar = xcd_barrier_post((unsigned*)(p.ws + WS_CTL), st);
#ifndef MK_ONLY
#define MK_ONLY -1
#endif
#define IN(k) (lo <= (k) && (k) < hi)
#define KIND(q) (MK_ONLY < 0 || MK_ONLY == (q))
#ifndef MK_TWICE
#define MK_TWICE -1
#endif
#define REP(q) for (int rep_ = 0; rep_ < ((MK_TWICE == (q)) ? 2 : 1); ++rep_)
#define SEAM(k) do { if (IN(k) && IN((k) + 1)) { xcd_barrier(bar); if (MK_TWICE == 30) xcd_barrier(bar); } } while (0)
    unsigned char* ws = p.ws;
    bf16_t* P = (bf16_t*)(ws + WS_P); bf16_t* H = (bf16_t*)(ws + WS_H);

    if (IN(0) && KIND(0)) REP(0) prologue_phase(p, L, G, c);
    SEAM(0);
    for (int l = 0; l < NLAYER; ++l) {
        const int pb = 1 + PPL * l;
        if (IN(pb + 0) && KIND(1)) REP(1) { Gemm g{H, (const bf16_t*)(ws + WS_WIN + (size_t)l * NP * 1024), T_TOK, NP, 512, 512, 512}; StaticOrder S; S.init(T_TOK, NP, G, c);
            pg8::EpiIn E{P, p.alpha_b + l * 256, (const float*)(ws + WS_WSC) + (size_t)l * NP, (const float*)(ws + WS_HSC)}; pg8::gemm_phase<pg8::EpiIn, StaticOrder, 2>(L, g, S, E, nullptr); }
        SEAM(pb + 0);
        if (IN(pb + 1) && KIND(2)) { if (MK_TWICE == 20) attn_phase(p, L, l, false, G, c, p.ph_lo == 0); attn_phase(p, L, l, false, G, c); if (MK_TWICE == 21) gla_a_phase(p, L, G, c); gla_a_phase(p, L, G, c); }
        SEAM(pb + 1);
        if (IN(pb + 2) && KIND(3)) { if (MK_TWICE == 22) gla_scan_phase(p, G, c); gla_scan_phase(p, G, c); if (MK_TWICE == 23) attn_phase(p, L, l, true, G, c, p.ph_lo == 0); attn_phase(p, L, l, true, G, c); }
        SEAM(pb + 2);
        if (IN(pb + 3) && KIND(4)) { if (MK_TWICE == 24) gla_c_phase(p, L, l, G, c, p.ph_lo == 0); gla_c_phase(p, L, l, G, c); if (MK_TWICE == 25) combine_phase(p, G, c, p.ph_lo == 0); combine_phase(p, G, c); }
        SEAM(pb + 3);
        if (IN(pb + 4) && KIND(5)) REP(5) { Gemm g{P, (const bf16_t*)(ws + WS_WBR) + (size_t)l * 3 * 1024 * 512, T_TOK, 1024, 512, 64, 512, (size_t)T_TOK * 128}; MergeOrder S; S.init(T_TOK, 1024, G, c);
            pg8::EpiMerge E{P, H}; pg8::gemm_phase<pg8::EpiMerge, MergeOrder>(L, g, S, E, nullptr); }
        SEAM(pb + 4);
        if (IN(pb + 5) && KIND(6)) REP(6) { Gemm g{H, (const bf16_t*)(ws + WS_WOUT) + (size_t)l * 1024 * 1024, T_TOK, 1024, 1024, 1024, 1024}; StaticOrder S; S.init(T_TOK, 1024, G, c);
            pg8::EpiResid E{l == 0 ? p.x : (const float*)p.out, p.out}; pg8::gemm_phase<pg8::EpiResid, StaticOrder>(L, g, S, E, nullptr); }
        SEAM(pb + 5);
        if (IN(pb + 6) && KIND(7)) REP(7) rmsnorm_phase<2>(p.out, p.norm_ffn + l * 1024, ws + WS_XQ, G, c, (float*)(ws + WS_XSC));
        SEAM(pb + 6);
        if (IN(pb + 7) && KIND(8)) REP(8) { Gemm g{(const bf16_t*)(ws + WS_XQ), (const bf16_t*)(ws + WS_WQ + (size_t)l * 2048 * 1024), T_TOK, 2048, 512, 512, 512}; StaticOrder S; S.init(T_TOK, 2048, G, c);
            pg8::EpiBfI8 E{(bf16_t*)(ws + WS_QY), 2048, (const float*)(ws + WS_WQSC) + (size_t)l * 2048, (const float*)(ws + WS_XSC)}; pg8::gemm_phase<pg8::EpiBfI8, StaticOrder, 2>(L, g, S, E, nullptr); }
        SEAM(pb + 7);
        if (IN(pb + 8) && KIND(9)) REP(9) peer_topk_phase(p, L, l, G, c);
        SEAM(pb + 8);
        if (IN(pb + 9) && KIND(10)) REP(10) peer_u_phase(p, l, G, c);
        SEAM(pb + 9);
        if (IN(pb + 10) && KIND(11)) REP(11) peer_w_phase(p, l, G, c);
        SEAM(pb + 10);
        if (IN(pb + 11) && KIND(12)) { if (MK_TWICE == 26) peer_v_phase(p, l, p.out, G, c, p.ph_lo == 0); peer_v_phase(p, l, p.out, G, c); }
        SEAM(pb + 11);
        if (IN(pb + 12) && KIND(13)) REP(13) { if (l + 1 < NLAYER) rmsnorm_phase<2>(p.out, p.norm_mix + (l + 1) * 1024, H, G, c, (float*)(ws + WS_HSC)); else rmsnorm_phase<0>(p.out, p.norm_final, p.out, G, c); }
        SEAM(pb + 12);
    }
#undef IN
#undef SEAM
}

extern "C" void kernel_launch(void* const* d_in, const int* in_sizes, int n_in, void* d_out, int out_size, void* d_ws, size_t ws_size, hipStream_t stream) {
    static int grid = 0;
    if (grid == 0) {
        if (n_in != 16 || out_size != T_TOK * DM || ws_size < WS_END) { fprintf(stderr, "kernel_launch: unexpected shapes (n_in %d, out %d, ws %zu < %zu)\n", n_in, out_size, ws_size, (size_t)WS_END); grid = -1; return; }
        int dev = 0, cus = 0, per_cu = 0;
        if (hipGetDevice(&dev) != hipSuccess || hipDeviceGetAttribute(&cus, hipDeviceAttributeMultiprocessorCount, dev) != hipSuccess) { grid = -1; return; }
        if (hipFuncSetAttribute((const void*)mega_fwd, hipFuncAttributeMaxDynamicSharedMemorySize, LDS_BYTES) != hipSuccess) { fprintf(stderr, "kernel_launch: hipFuncSetAttribute failed\n"); grid = -1; return; }
        if (hipOccupancyMaxActiveBlocksPerMultiprocessor(&per_cu, (const void*)mega_fwd, 512, LDS_BYTES) != hipSuccess || per_cu < 1) { fprintf(stderr, "kernel_launch: occupancy query says %d\n", per_cu); (void)hipGetLastError(); grid = -1; return; }
        grid = cus;
    }
    if (grid < 0) return;
    (void)hipMemsetAsync((char*)d_ws + WS_CTL, 0, CTL_BYTES, stream);
    Params p{};
    p.x = (const float*)d_in[0]; p.w_in = (const float*)d_in[1]; p.sinks = (const float*)d_in[2]; p.alpha_w = (const float*)d_in[3]; p.alpha_b = (const float*)d_in[4]; p.head_norm = (const float*)d_in[5];
    p.w_branch = (const float*)d_in[6]; p.w_out = (const float*)d_in[7]; p.norm_mix = (const float*)d_in[8]; p.norm_ffn = (const float*)d_in[9]; p.peer_wq = (const float*)d_in[10]; p.peer_keys = (const float*)d_in[11];
    p.peer_u = (const float*)d_in[12]; p.peer_v = (const float*)d_in[13]; p.rel_bias = (const float*)d_in[14]; p.norm_final = (const float*)d_in[15];
    p.out = (float*)d_out; p.ws = (unsigned char*)d_ws;
#if MK_PER_PHASE
    for (int k = 0; k < N_PHASES; ++k) { p.ph_lo = k; p.ph_hi = k + 1; hipLaunchKernelGGL(mega_fwd, dim3(grid), dim3(512), LDS_BYTES, stream, p); }
#else
    p.ph_lo = 0; p.ph_hi = N_PHASES;
    hipLaunchKernelGGL(mega_fwd, dim3(grid), dim3(512), LDS_BYTES, stream, p);
#endif
}
```

```cpp
#include <hip/hip_runtime.h>
#include <cstdio>
#include <cstdint>

#define LAS __attribute__((address_space(3)))
typedef unsigned short bf16_t;
typedef short bf16x8 __attribute__((ext_vector_type(8)));
typedef float f32x4 __attribute__((ext_vector_type(4)));
typedef float f32x2 __attribute__((ext_vector_type(2)));
typedef unsigned u32x4 __attribute__((ext_vector_type(4)));
typedef unsigned u32x2 __attribute__((ext_vector_type(2)));

constexpr int T_TOK = 16384, DM = 1024, SEQ = 2048, NBATCH = 8, NLAYER = 2;
constexpr int NP = 10240;
constexpr int C_QA = 0, C_KA = 512, C_VA = 640;
constexpr int C_B0 = 768;
constexpr int C_QC = 5376, C_KC = 5632, C_VC = 5888, C_RC = 6400, C_Z = 6912, C_G = 7168;
constexpr int IN_W = 10000;
constexpr int NEXP = 16384;

constexpr size_t WS_CTL   = 0;
constexpr size_t CTL_BYTES = 65536;
constexpr size_t WS_LUT   = WS_CTL + CTL_BYTES;
constexpr size_t WS_DECAY = WS_LUT + 32768;
constexpr size_t WS_LSE   = WS_DECAY + 262144;
constexpr size_t WS_USC   = WS_LSE + 1572864;
constexpr size_t WS_VSC   = WS_USC + 131072;
constexpr size_t WS_WSC   = WS_VSC + 131072;
constexpr size_t WS_HSC   = WS_WSC + 131072;
constexpr size_t WS_XSC   = WS_HSC + 65536;
constexpr size_t WS_WQSC  = WS_XSC + 65536;
constexpr size_t WS_TSC   = WS_WQSC + 16384;
constexpr size_t WS_P     = WS_TSC + 65536;
constexpr size_t WS_H     = WS_P + (size_t)T_TOK * NP * 2;
constexpr size_t WS_SPREV = WS_H + (size_t)T_TOK * DM * 2;
constexpr size_t WS_XQ    = WS_SPREV;
constexpr size_t WS_WIN   = WS_SPREV + 16777216;
constexpr size_t WS_WBR   = WS_WIN + (size_t)2 * NP * 1024 * 2;
constexpr size_t WS_WOUT  = WS_WBR + (size_t)2 * 3 * 1024 * 512 * 2;
constexpr size_t WS_WQ    = WS_WOUT + (size_t)2 * 1024 * 1024 * 2;
constexpr size_t WS_KEYS  = WS_WQ + (size_t)2 * 2048 * 1024 * 2;
constexpr size_t WS_U8    = WS_KEYS + (size_t)2 * 8 * 2 * 128 * 128 * 2;
constexpr size_t WS_V8    = WS_U8 + (size_t)2 * NEXP * 1024;
constexpr size_t WS_END   = WS_V8 + (size_t)2 * NEXP * 1024;
constexpr size_t WS_QY    = WS_P;
constexpr size_t WS_IDX   = WS_QY + (size_t)T_TOK * 2048 * 2;
constexpr size_t WS_GATE  = WS_IDX + (size_t)T_TOK * 128 * 4;
constexpr size_t WS_HIDP  = WS_GATE + (size_t)T_TOK * 128 * 4;
constexpr size_t WS_EW    = WS_HIDP + (size_t)T_TOK * 128 * 8 * 4;
static_assert(WS_EW + (size_t)T_TOK * 128 * 8 <= WS_H, "peer alias");
static_assert(WS_END <= (size_t)536870912, "workspace");

constexpr int LDS_BYTES = 147456;
constexpr int LDS_MISC = 131072;

struct Params {
    const float *x, *w_in, *sinks, *alpha_w, *alpha_b, *head_norm, *w_branch, *w_out, *norm_mix, *norm_ffn, *peer_wq, *peer_keys, *peer_u, *peer_v, *rel_bias, *norm_final;
    float* out; unsigned char* ws; int ph_lo, ph_hi;
};

__device__ __forceinline__ float bf2f(unsigned short b) { return __uint_as_float(((unsigned)b) << 16); }
__device__ __forceinline__ float bflo(unsigned u) { return __uint_as_float(u << 16); }
__device__ __forceinline__ float bfhi(unsigned u) { return __uint_as_float(u & 0xffff0000u); }
__device__ __forceinline__ unsigned cvt_pk_bf16(float lo, float hi) { unsigned r; asm("v_cvt_pk_bf16_f32 %0, %1, %2" : "=v"(r) : "v"(lo), "v"(hi)); return r; }
__device__ __forceinline__ float fexp(float x) { return __builtin_amdgcn_exp2f(x * 1.4426950408889634f); }
__device__ __forceinline__ float flog(float x) { return __builtin_amdgcn_logf(x) * 0.6931471805599453f; }
__device__ __forceinline__ float fsigmoid(float x) { return __builtin_amdgcn_rcpf(1.0f + fexp(-x)); }
__device__ __forceinline__ float flogsigmoid(float z) { return fminf(z, 0.f) - flog(1.0f + fexp(-fabsf(z))); }
__device__ __forceinline__ float fgelu_tanh(float x) { const float u = 0.7978845608028654f * (x + 0.044715f * x * x * x); return x * fsigmoid(2.0f * u); }
__device__ __forceinline__ float wave_sum(float v) {
#pragma unroll
    for (int o = 32; o >= 1; o >>= 1) v += __shfl_xor(v, o);
    return v;
}
__device__ __forceinline__ float wave_max(float v) {
#pragma unroll
    for (int o = 32; o >= 1; o >>= 1) v = fmaxf(v, __shfl_xor(v, o));
    return v;
}
__device__ __forceinline__ size_t pidx(size_t row, int col) { return ((size_t)(col >> 6) * T_TOK + row) * 64 + (size_t)(col & 63); }
#define WG_SYNC() __syncthreads()
__device__ __forceinline__ unsigned pack_i8x4(float a, float b, float c, float d) {
    const int ia = (int)__builtin_rintf(a), ib = (int)__builtin_rintf(b), ic = (int)__builtin_rintf(c), id = (int)__builtin_rintf(d);
    return (unsigned)(ia & 0xff) | ((unsigned)(ib & 0xff) << 8) | ((unsigned)(ic & 0xff) << 16) | ((unsigned)id << 24); }
__device__ __forceinline__ int opaque_tid() { int t = (int)threadIdx.x; asm volatile("" : "+v"(t)); return t; }


#define XB_TMO      128
#define XB_XCNT(j)  (256  + 64 * (j))
#define XB_XSUB(j)  (1280 + 64 * (j))
#define XB_XGEN(j)  (2304 + 64 * (j))
#define XB_TOP      3328
#define XB_TOPGEN   3392
#define XCD_BAR_WORDS 3456
#define XB_SPIN_CAP (1u << 18)

__device__ __forceinline__ unsigned xb_ld(unsigned* p)              { return __hip_atomic_load(p, __ATOMIC_RELAXED, __HIP_MEMORY_SCOPE_AGENT); }
__device__ __forceinline__ unsigned xb_add(unsigned* p, unsigned v) { return __hip_atomic_fetch_add(p, v, __ATOMIC_RELAXED, __HIP_MEMORY_SCOPE_AGENT); }
__device__ __forceinline__ unsigned xb_xcc_id() { return (unsigned)__builtin_amdgcn_s_getreg((3 << 11) | 20) & 0xFu; }
#define XB_SPIN(cond, bar) do { unsigned _sp = 0; while (cond) { __builtin_amdgcn_s_sleep(1); \
    if ((++_sp & 255u) == 0u) { if (xb_ld(&(bar)[XB_TMO])) break; if (_sp > XB_SPIN_CAP) { atomicAdd(&(bar)[XB_TMO], 1u); break; } } } } while (0)

struct XcdBarrier {
    unsigned* bar; unsigned x;
    volatile LAS unsigned* st;
};

__device__ __forceinline__ XcdBarrier xcd_barrier_post(unsigned* bar, volatile LAS unsigned* st) {
    XcdBarrier b; b.bar = bar; b.x = xb_xcc_id(); b.st = st;
    if (threadIdx.x == 0) (void)xb_add(&bar[XB_XCNT(b.x)], 1u);
    return b;
}
__device__ __forceinline__ void xcd_barrier_complete(unsigned* bar, unsigned x, unsigned& nloc, unsigned& nx) {
    const unsigned G = gridDim.x * gridDim.y * gridDim.z;
    unsigned sum, cnt, mine, sp = 0u;
    for (;;) {
        sum = 0u; cnt = 0u; mine = 0u;
#pragma unroll
        for (unsigned j = 0; j < 16; ++j) { const unsigned c = xb_ld(&bar[XB_XCNT(j)]); sum += c; cnt += (c > 0u) ? 1u : 0u; mine = (j == x) ? c : mine; }
        if (sum == G) break;
        __builtin_amdgcn_s_sleep(1);
        if ((++sp & 255u) == 0u) { if (xb_ld(&bar[XB_TMO])) break; if (sp > XB_SPIN_CAP) { atomicAdd(&bar[XB_TMO], 1u); break; } }
    }
    nloc = mine > 0u ? mine : 1u; nx = cnt > 0u ? cnt : 1u;
}

__device__ __forceinline__ void xcd_barrier(const XcdBarrier& b) {
    asm volatile("s_waitcnt vmcnt(0)" ::: "memory");
    __syncthreads();
    if (threadIdx.x == 0) {
        unsigned* bar = b.bar;
        __builtin_amdgcn_s_waitcnt(0);
        unsigned nloc = b.st[0], nx = b.st[1];
        if (nloc == 0u) { xcd_barrier_complete(bar, b.x, nloc, nx); b.st[0] = nloc; b.st[1] = nx; }
        const unsigned old = xb_add(&bar[XB_XSUB(b.x)], 1u);
        const unsigned gen = old / nloc;
        if (old + 1u == (gen + 1u) * nloc) {
            __builtin_amdgcn_fence(__ATOMIC_RELEASE, "agent");
            asm volatile("s_waitcnt vmcnt(0)" ::: "memory");
            const unsigned og = xb_add(&bar[XB_TOP], 1u);
            const unsigned tg = og / nx;
            if (og + 1u == (tg + 1u) * nx) xb_add(&bar[XB_TOPGEN], 1u);
            else XB_SPIN(xb_ld(&bar[XB_TOPGEN]) == tg, bar);
            __builtin_amdgcn_fence(__ATOMIC_ACQUIRE, "agent");
            xb_add(&bar[XB_XGEN(b.x)], 1u);
            asm volatile("s_waitcnt vmcnt(0)" ::: "memory");
        } else {
            XB_SPIN(xb_ld(&bar[XB_XGEN(b.x)]) == gen, bar);
            __builtin_amdgcn_fence(__ATOMIC_ACQUIRE, "agent");
            asm volatile("s_waitcnt vmcnt(0)" ::: "memory");
        }
    }
    __syncthreads();
}

namespace pg8 {
#define PG8_LAS __attribute__((address_space(3)))
constexpr int BM = 256, BK = 64, HALF = 128, HTB = HALF * BK * 2  , STAGE_BYTES = 8 * HTB, NXCD = 8, WGM = 8;

__host__ __device__ __forceinline__ int lds_byte(int r, int c) { const int st = (r >> 4) * 2 + (c >> 5), rr = r & 15, cc = c & 31, ob = rr * 64 + cc * 2; return st * 1024 + (ob ^ (((ob >> 9) & 1) << 5)); }
__host__ __device__ __forceinline__ void stage_rc(int b, int& R, int& C) { const int st = b / 1024, sb = b % 1024, swz = sb ^ (((sb >> 9) & 1) << 5); R = (st >> 1) * 16 + swz / 64; C = (st & 1) * 32 + (swz % 64) / 2; }
__host__ __device__ __forceinline__ int perm32(int rho) { const int n = rho >> 4, i = rho & 15; return 8 * (i >> 2) + 4 * n + (i & 3); }

struct Unit { int pm, pn, z; };
struct Gemm { const bf16_t* A; const bf16_t* Bt; int M, N, K, lda, ldb; size_t ksA; };

struct StaticOrder {
    int nM, nN, nwg, G, c;
    __host__ __device__ void init(int M, int N, int G_, int c_) { nM = M / BM; nN = N / BM; nwg = nM * nN; G = G_; c = c_; }
    __host__ __device__ bool next(int i, Unit& u) const {
        const long L = (long)i * G + c; if (L >= nwg) return false;
        int wgid = (int)L; { const int q = nwg / NXCD, r = nwg % NXCD, xcd = wgid % NXCD, off = wgid / NXCD; wgid = (xcd < r ? xcd * (q + 1) : r * (q + 1) + (xcd - r) * q) + off; }
        const int nig = WGM * nN, gid = wgid / nig, fm = gid * WGM, gsz = (nM - fm) < WGM ? (nM - fm) : WGM;
        u.pm = fm + ((wgid % nig) % gsz); u.pn = (wgid % nig) / gsz; u.z = 0; return true;
    }
    __device__ __forceinline__ const char* ptrA(const Gemm& g, const Unit& u) const { return (const char*)g.A + (size_t)u.pm * BM * g.lda * 2; }
    __device__ __forceinline__ const char* ptrB(const Gemm& g, const Unit& u) const { return (const char*)g.Bt + (size_t)u.pn * BM * g.ldb * 2; }
    __device__ __forceinline__ void a_ready(const Unit&) const {}
    __device__ __forceinline__ void done(const Unit&) const {}
};


typedef int v8i_t __attribute__((ext_vector_type(8)));
typedef int v4i_t __attribute__((ext_vector_type(4)));
__device__ __forceinline__ v8i_t cat8(bf16x8 a, bf16x8 b) { const v4i_t x = __builtin_bit_cast(v4i_t, a), y = __builtin_bit_cast(v4i_t, b); return __builtin_shufflevector(x, y, 0, 1, 2, 3, 4, 5, 6, 7); }

struct EpiIn {
    static constexpr bool PERM = true, AFTER_DRAIN = false;
    bf16_t* O; const float* zbias; const float* wsc; const float* hsc;
    __device__ __forceinline__ void operator()(const f32x4 (&acc)[2][2][4][2], const Unit& u, int wr, int wc, int fr, int fq) const {
        const int row0 = u.pm * BM + wr * 64 + fr; const int cin = wc * 32 + 8 * fq; const int col0 = u.pn * BM + cin;
        const int mode = (u.pn >= 28) ? 2 : (u.pn == 27 ? 1 : 0);
        f32x4 bv[2][2], sv[2][2];
#pragma unroll
        for (int bj = 0; bj < 2; ++bj)
#pragma unroll
            for (int n = 0; n < 2; ++n) { bv[bj][n] = (mode == 1) ? *(const f32x4*)(zbias + cin + bj * HALF + 4 * n) : (f32x4){0.f, 0.f, 0.f, 0.f}; sv[bj][n] = *(const f32x4*)(wsc + col0 + bj * HALF + 4 * n); }
        float hsv[2][4];
#pragma unroll
        for (int ai = 0; ai < 2; ++ai)
#pragma unroll
            for (int m = 0; m < 4; ++m) hsv[ai][m] = hsc[row0 + ai * HALF + m * 16];
#pragma unroll
        for (int ai = 0; ai < 2; ++ai)
#pragma unroll
            for (int m = 0; m < 4; ++m) { const size_t orow = (size_t)(row0 + ai * HALF + m * 16); const float hs = hsv[ai][m];
#pragma unroll
                for (int bj = 0; bj < 2; ++bj) { const v4i_t i0 = __builtin_bit_cast(v4i_t, acc[ai][bj][m][0]), i1 = __builtin_bit_cast(v4i_t, acc[ai][bj][m][1]);
                    f32x4 v0 = (f32x4){(float)i0[0], (float)i0[1], (float)i0[2], (float)i0[3]} * (sv[bj][0] * hs) + bv[bj][0], v1 = (f32x4){(float)i1[0], (float)i1[1], (float)i1[2], (float)i1[3]} * (sv[bj][1] * hs) + bv[bj][1];
                    if (mode == 2) {
#pragma unroll
                        for (int j = 0; j < 4; ++j) { v0[j] = fsigmoid(v0[j]); v1[j] = fsigmoid(v1[j]); } }
                    if (mode == 1) {
#pragma unroll
                        for (int j = 0; j < 4; ++j) { v0[j] = flogsigmoid(v0[j]) * 0.0625f; v1[j] = flogsigmoid(v1[j]) * 0.0625f; } }
                    u32x4 w; w.x = cvt_pk_bf16(v0[0], v0[1]); w.y = cvt_pk_bf16(v0[2], v0[3]); w.z = cvt_pk_bf16(v1[0], v1[1]); w.w = cvt_pk_bf16(v1[2], v1[3]);
                    __builtin_nontemporal_store(w, (u32x4*)(O + pidx(orow, col0 + bj * HALF))); } }
    }
};
struct EpiBf {
    static constexpr bool PERM = true, AFTER_DRAIN = false;
    bf16_t* O; int ldc;
    __device__ __forceinline__ void operator()(const f32x4 (&acc)[2][2][4][2], const Unit& u, int wr, int wc, int fr, int fq) const {
        const int row0 = u.pm * BM + wr * 64 + fr; const int col0 = u.pn * BM + wc * 32 + 8 * fq;
#pragma unroll
        for (int ai = 0; ai < 2; ++ai)
#pragma unroll
            for (int m = 0; m < 4; ++m) { bf16_t* rowp = O + (size_t)(row0 + ai * HALF + m * 16) * ldc + col0;
#pragma unroll
                for (int bj = 0; bj < 2; ++bj) { const f32x4 v0 = acc[ai][bj][m][0], v1 = acc[ai][bj][m][1];
                    u32x4 w; w.x = cvt_pk_bf16(v0[0], v0[1]); w.y = cvt_pk_bf16(v0[2], v0[3]); w.z = cvt_pk_bf16(v1[0], v1[1]); w.w = cvt_pk_bf16(v1[2], v1[3]);
                    *(u32x4*)(rowp + bj * HALF) = w; } }
    }
};
struct EpiBfI8 {
    static constexpr bool PERM = true, AFTER_DRAIN = false;
    bf16_t* O; int ldc; const float* wsc; const float* hsc;
    __device__ __forceinline__ void operator()(const f32x4 (&acc)[2][2][4][2], const Unit& u, int wr, int wc, int fr, int fq) const {
        const int row0 = u.pm * BM + wr * 64 + fr; const int col0 = u.pn * BM + wc * 32 + 8 * fq;
        f32x4 sv[2][2];
#pragma unroll
        for (int bj = 0; bj < 2; ++bj)
#pragma unroll
            for (int n = 0; n < 2; ++n) sv[bj][n] = *(const f32x4*)(wsc + col0 + bj * HALF + 4 * n);
        float hsv[2][4];
#pragma unroll
        for (int ai = 0; ai < 2; ++ai)
#pragma unroll
            for (int m = 0; m < 4; ++m) hsv[ai][m] = hsc[row0 + ai * HALF + m * 16];
#pragma unroll
        for (int ai = 0; ai < 2; ++ai)
#pragma unroll
            for (int m = 0; m < 4; ++m) { bf16_t* rowp = O + (size_t)(row0 + ai * HALF + m * 16) * ldc + col0; const float hs = hsv[ai][m];
#pragma unroll
                for (int bj = 0; bj < 2; ++bj) { const v4i_t i0 = __builtin_bit_cast(v4i_t, acc[ai][bj][m][0]), i1 = __builtin_bit_cast(v4i_t, acc[ai][bj][m][1]);
                    const f32x4 v0 = (f32x4){(float)i0[0], (float)i0[1], (float)i0[2], (float)i0[3]} * (sv[bj][0] * hs), v1 = (f32x4){(float)i1[0], (float)i1[1], (float)i1[2], (float)i1[3]} * (sv[bj][1] * hs);
                    u32x4 w; w.x = cvt_pk_bf16(v0[0], v0[1]); w.y = cvt_pk_bf16(v0[2], v0[3]); w.z = cvt_pk_bf16(v1[0], v1[1]); w.w = cvt_pk_bf16(v1[2], v1[3]);
                    *(u32x4*)(rowp + bj * HALF) = w; } }
    }
};
struct EpiMerge {
    static constexpr bool PERM = true, AFTER_DRAIN = false;
    const bf16_t* Pm; bf16_t* MG;
    __device__ __forceinline__ void operator()(const f32x4 (&acc)[2][2][4][2], const Unit& u, int wr, int wc, int fr, int fq) const {
        const int row0 = u.pm * BM + wr * 64 + fr; const int col0 = u.pn * BM + wc * 32 + 8 * fq; const int z = u.z;
#pragma unroll
        for (int ai = 0; ai < 2; ++ai) {
            u32x4 gw[4][2], pw[4][2];
#pragma unroll
            for (int m = 0; m < 4; ++m) { const int row = row0 + ai * HALF + m * 16;
                const bf16_t* mp = MG + (size_t)row * DM + col0;
#pragma unroll
                for (int bj = 0; bj < 2; ++bj) { gw[m][bj] = *(const u32x4*)(Pm + pidx((size_t)row, C_G + 1024 * z + col0 + bj * HALF)); pw[m][bj] = (z > 0) ? *(const u32x4*)(mp + bj * HALF) : (u32x4){0u, 0u, 0u, 0u}; } }
#pragma unroll
            for (int m = 0; m < 4; ++m) { const int row = row0 + ai * HALF + m * 16; bf16_t* mp = MG + (size_t)row * DM + col0;
#pragma unroll
                for (int bj = 0; bj < 2; ++bj) { const u32x4 g = gw[m][bj], q = pw[m][bj]; const f32x4 v0 = acc[ai][bj][m][0], v1 = acc[ai][bj][m][1];
                    u32x4 w;
                    w.x = cvt_pk_bf16(bflo(q.x) + bflo(g.x) * v0[0], bfhi(q.x) + bfhi(g.x) * v0[1]); w.y = cvt_pk_bf16(bflo(q.y) + bflo(g.y) * v0[2], bfhi(q.y) + bfhi(g.y) * v0[3]);
                    w.z = cvt_pk_bf16(bflo(q.z) + bflo(g.z) * v1[0], bfhi(q.z) + bfhi(g.z) * v1[1]); w.w = cvt_pk_bf16(bflo(q.w) + bflo(g.w) * v1[2], bfhi(q.w) + bfhi(g.w) * v1[3]);
                    *(u32x4*)(mp + bj * HALF) = w; } }
        }
    }
};
struct EpiResid {
    static constexpr bool PERM = false, AFTER_DRAIN = false;
    const float* src; float* dst;
    __device__ __forceinline__ void operator()(const f32x4 (&acc)[2][2][4][2], const Unit& u, int wr, int wc, int fr, int fq) const {
        const int row0 = u.pm * BM + wr * 64 + fr, col0 = u.pn * BM + wc * 32 + 4 * fq;
#pragma unroll
        for (int ai = 0; ai < 2; ++ai) {
            f32x4 b[4][2][2];
#pragma unroll
            for (int m = 0; m < 4; ++m) { const size_t off = (size_t)(row0 + ai * HALF + m * 16) * DM + col0;
#pragma unroll
                for (int bj = 0; bj < 2; ++bj)
#pragma unroll
                    for (int n = 0; n < 2; ++n) b[m][bj][n] = *(const f32x4*)(src + off + bj * HALF + n * 16); }
#pragma unroll
            for (int m = 0; m < 4; ++m) { const size_t off = (size_t)(row0 + ai * HALF + m * 16) * DM + col0;
#pragma unroll
                for (int bj = 0; bj < 2; ++bj)
#pragma unroll
                    for (int n = 0; n < 2; ++n) *(f32x4*)(dst + off + bj * HALF + n * 16) = b[m][bj][n] + acc[ai][bj][m][n]; }
        }
    }
};

template <class Epi, class Sched, int MODE = 0, bool STAMP = false>
__device__ __forceinline__ void gemm_phase(PG8_LAS unsigned char* lds, const Gemm g, const Sched& S, const Epi& E, unsigned long long* stamps) {
    const int tid = opaque_tid(), wid = __builtin_amdgcn_readfirstlane(tid >> 6), lane = tid & 63, wr = wid >> 2, wc = wid & 3, fr = lane & 15, fq = lane >> 4;
    const int K = g.K, nt = K / BK;
    int ts_lo = 0, ts_hi = 0, nts = 0; const unsigned long long rt_entry = STAMP ? (unsigned long long)wall_clock64() : 0ull;
#define PG8_STAMP() do { if (STAMP && wid == 0 && nts < 64) { const unsigned long long _c = (unsigned long long)clock64(); \
        ts_lo = (lane == nts) ? (int)(unsigned)_c : ts_lo; ts_hi = (lane == nts) ? (int)(unsigned)(_c >> 32) : ts_hi; ++nts; } } while (0)
    PG8_STAMP();
    unsigned voffA[2], voffB[2];
#pragma unroll
    for (int i = 0; i < 2; ++i) { int R, C; stage_rc(tid * 16 + i * 8192, R, C); const int Rb = Epi::PERM ? ((R & ~31) + perm32(R & 31)) : R;
        voffA[i] = (unsigned)(R * g.lda + C) * 2u; voffB[i] = (unsigned)(Rb * g.ldb + C) * 2u; }
    const size_t kstepB = (size_t)(BK * 2), kstepA = g.ksA ? g.ksA : (size_t)(BK * 2);
    const size_t hstepA = (size_t)HALF * g.lda * 2, hstepB = (size_t)HALF * g.ldb * 2;
    const unsigned ldsw = (unsigned)wid * 1024u;
    const int aoff = lds_byte(wr * 64 + fr, fq * 8), boff = lds_byte(wc * 32 + fr, fq * 8);
#define PG8_SA(b, h) (((b) * 2 + (h)) * HTB)
#define PG8_SB(b, h) ((4 + (b) * 2 + (h)) * HTB)
#define PG8_STAGE(bufoff, gbase, voff) do { _Pragma("unroll") for (int _i = 0; _i < 2; ++_i) \
        __builtin_amdgcn_global_load_lds((const unsigned*)((const char*)(gbase) + (voff)[_i]), (PG8_LAS unsigned*)(lds + (bufoff) + ldsw + _i * 8192), 16, 0, 0); } while (0)
#define PG8_LDA(dst, b, h) do { _Pragma("unroll") for (int m = 0; m < 4; ++m) _Pragma("unroll") for (int k = 0; k < 2; ++k) dst[m][k] = *(const PG8_LAS bf16x8*)(lds + PG8_SA(b, h) + aoff + m * 2048 + k * 1024); } while (0)
#define PG8_LDB(dst, b, h) do { _Pragma("unroll") for (int n = 0; n < 2; ++n) _Pragma("unroll") for (int k = 0; k < 2; ++k) dst[n][k] = *(const PG8_LAS bf16x8*)(lds + PG8_SB(b, h) + boff + n * 2048 + k * 1024); } while (0)
#define PG8_MMA(ai, bj, At, Bt) do { __builtin_amdgcn_s_setprio(1); _Pragma("unroll") for (int m = 0; m < 4; ++m) _Pragma("unroll") for (int n = 0; n < 2; ++n) { \
        if constexpr (MODE == 1) { asm volatile("v_mfma_f32_16x16x128_f8f6f4 %0, %1, %2, %0" : "+v"(acc[ai][bj][m][n]) : "v"(cat8(Bt[n][0], Bt[n][1])), "v"(cat8(At[m][0], At[m][1]))); } \
        else if constexpr (MODE == 2) { _Pragma("unroll") for (int k = 0; k < 2; ++k) acc[ai][bj][m][n] = __builtin_bit_cast(f32x4, __builtin_amdgcn_mfma_i32_16x16x64_i8(__builtin_bit_cast(v4i_t, Bt[n][k]), __builtin_bit_cast(v4i_t, At[m][k]), __builtin_bit_cast(v4i_t, acc[ai][bj][m][n]), 0, 0, 0)); } \
        else { _Pragma("unroll") for (int k = 0; k < 2; ++k) acc[ai][bj][m][n] = __builtin_amdgcn_mfma_f32_16x16x32_bf16(Bt[n][k], At[m][k], acc[ai][bj][m][n], 0, 0, 0); } } \
        __builtin_amdgcn_s_setprio(0); } while (0)
#define PG8_WAIT_V(n) asm volatile("s_waitcnt vmcnt(" #n ")" ::: "memory")
#define PG8_WAIT_L(n) asm volatile("s_waitcnt lgkmcnt(" #n ")" ::: "memory")
#define PG8_BAR __builtin_amdgcn_s_barrier()
#define PG8_SCHED __builtin_amdgcn_sched_barrier(0)
    Unit cur, nxt; int ui = 0;
    if (!S.next(0, cur)) return;
    f32x4 acc[2][2][4][2];
#pragma unroll
    for (int a = 0; a < 2; ++a)
#pragma unroll
        for (int b = 0; b < 2; ++b)
#pragma unroll
            for (int m = 0; m < 4; ++m)
#pragma unroll
                for (int n = 0; n < 2; ++n) acc[a][b][m][n] = (f32x4){0.f, 0.f, 0.f, 0.f};
    bf16x8 At[4][2], B0[2][2], B1[2][2];
    const char* cA = S.ptrA(g, cur); const char* cB = S.ptrB(g, cur);
    S.a_ready(cur);
    PG8_STAGE(PG8_SB(0, 0), cB, voffB); PG8_STAGE(PG8_SA(0, 0), cA, voffA); PG8_STAGE(PG8_SB(0, 1), cB + hstepB, voffB); PG8_STAGE(PG8_SA(0, 1), cA + hstepA, voffA);
    if (wr == 1) PG8_BAR;
    PG8_WAIT_V(4); PG8_BAR;
    PG8_STAGE(PG8_SB(1, 0), cB + kstepB, voffB); PG8_STAGE(PG8_SA(1, 0), cA + kstepA, voffA); PG8_STAGE(PG8_SB(1, 1), cB + hstepB + kstepB, voffB);
    PG8_WAIT_V(6); PG8_BAR;
    PG8_STAMP();
    for (;;) {
        const bool has_next = S.next(ui + 1, nxt);
        const char* nA = has_next ? S.ptrA(g, nxt) : cA; const char* nB = has_next ? S.ptrB(g, nxt) : cB;
#pragma nounroll
        for (int t = 0; t < nt; t += 2) {
            const bool last = (t == nt - 2);
            const char* a1 = cA + (size_t)(t + 1) * kstepA;
            const char* a2 = last ? nA : cA + (size_t)(t + 2) * kstepA; const char* b2 = last ? nB : cB + (size_t)(t + 2) * kstepB;
            const char* a3 = a2 + kstepA; const char* b3 = b2 + kstepB;
            if (last && has_next) S.a_ready(nxt);
            PG8_LDB(B0, 0, 0); PG8_SCHED; PG8_LDA(At, 0, 0); PG8_STAGE(PG8_SA(1, 1), a1 + hstepA, voffA);
            PG8_WAIT_L(8); PG8_BAR; PG8_WAIT_L(0); PG8_MMA(0, 0, At, B0); PG8_BAR; PG8_SCHED;
            PG8_LDB(B1, 0, 1); PG8_STAGE(PG8_SB(0, 0), b2, voffB);
            PG8_BAR; PG8_WAIT_L(0); PG8_MMA(0, 1, At, B1); PG8_BAR;
            PG8_LDA(At, 0, 1); PG8_STAGE(PG8_SA(0, 0), a2, voffA);
            PG8_BAR; PG8_WAIT_L(0); PG8_MMA(1, 0, At, B0); PG8_BAR; PG8_SCHED;
            PG8_STAGE(PG8_SB(0, 1), b2 + hstepB, voffB);
            PG8_WAIT_V(6); PG8_BAR; PG8_MMA(1, 1, At, B1); PG8_BAR;
            PG8_LDB(B0, 1, 0); PG8_SCHED; PG8_LDA(At, 1, 0); PG8_STAGE(PG8_SA(0, 1), a2 + hstepA, voffA);
            PG8_WAIT_L(8); PG8_BAR; PG8_WAIT_L(0); PG8_MMA(0, 0, At, B0); PG8_BAR; PG8_SCHED;
            PG8_LDB(B1, 1, 1); PG8_STAGE(PG8_SB(1, 0), b3, voffB);
            PG8_BAR; PG8_WAIT_L(0); PG8_MMA(0, 1, At, B1); PG8_BAR;
            PG8_LDA(At, 1, 1); PG8_STAGE(PG8_SA(1, 0), a3, voffA);
            PG8_BAR; PG8_WAIT_L(0); PG8_MMA(1, 0, At, B0); PG8_BAR; PG8_SCHED;
            PG8_STAGE(PG8_SB(1, 1), b3 + hstepB, voffB);
            PG8_WAIT_V(6); PG8_BAR; PG8_MMA(1, 1, At, B1); PG8_BAR;
        }
        if constexpr (MODE == 1) asm volatile("s_nop 15\n\ts_nop 15" ::: "memory");
        PG8_STAMP();
        if constexpr (!Epi::AFTER_DRAIN) { E(acc, cur, wr, wc, fr, fq); S.done(cur); }
        PG8_STAMP();
        if (!has_next) break;
#pragma unroll
        for (int a = 0; a < 2; ++a)
#pragma unroll
            for (int b = 0; b < 2; ++b)
#pragma unroll
                for (int m = 0; m < 4; ++m)
#pragma unroll
                    for (int n = 0; n < 2; ++n) acc[a][b][m][n] = (f32x4){0.f, 0.f, 0.f, 0.f};
        cur = nxt; cA = nA; cB = nB; ++ui;
    }
    PG8_WAIT_V(0);
    if (wr == 0) PG8_BAR;
    PG8_BAR;
    if constexpr (Epi::AFTER_DRAIN) { E.fused(acc, cur, wr, wc, fr, fq, lds, wid, lane); S.done(cur); }
    PG8_STAMP();
    if (STAMP && wid == 0) { stamps[lane] = lane < nts ? (((unsigned long long)(unsigned)ts_hi << 32) | (unsigned)ts_lo) : 0ull;
        if (lane == 62) stamps[62] = rt_entry; if (lane == 63) stamps[63] = (unsigned long long)wall_clock64(); }
#undef PG8_STAMP
#undef PG8_SA
#undef PG8_SB
#undef PG8_STAGE
#undef PG8_LDA
#undef PG8_LDB
#undef PG8_MMA
#undef PG8_WAIT_V
#undef PG8_WAIT_L
#undef PG8_BAR
#undef PG8_SCHED
}
}

using pg8::Unit; using pg8::Gemm; using pg8::StaticOrder;

struct MergeOrder : StaticOrder {
    __device__ __forceinline__ bool next(int i, Unit& u) const { if (!StaticOrder::next(i / 3, u)) return false; u.z = i % 3; return true; }
    __device__ __forceinline__ const char* ptrA(const Gemm& g, const Unit& u) const { const int col = (u.z == 0) ? C_QA : (u.z == 1 ? C_B0 : C_VC); return (const char*)g.A + ((size_t)(col >> 6) * T_TOK + (size_t)u.pm * pg8::BM) * 128; }
    __device__ __forceinline__ const char* ptrB(const Gemm& g, const Unit& u) const { return (const char*)(g.Bt + (size_t)u.z * 1024 * 512) + (size_t)u.pn * pg8::BM * g.ldb * 2; }
};

template <int OUT_MODE>
__device__ __forceinline__ void rmsnorm_phase(const float* src, const float* gain, void* dst, int G, int c, float* hsc = nullptr, unsigned char* dst8 = nullptr) {
    const int tid = opaque_tid(), lane = tid & 63, wid = tid >> 6;
    f32x4 gv[4];
#pragma unroll
    for (int q = 0; q < 4; ++q) gv[q] = *(const f32x4*)(gain + 256 * q + 4 * lane);
    for (int row = c * 8 + wid; row < T_TOK; row += G * 8) {
        f32x4 v[4]; float ss = 0.f;
#pragma unroll
        for (int q = 0; q < 4; ++q) { v[q] = *(const f32x4*)(src + (size_t)row * DM + 256 * q + 4 * lane); ss += v[q][0] * v[q][0] + v[q][1] * v[q][1] + v[q][2] * v[q][2] + v[q][3] * v[q][3]; }
        ss = wave_sum(ss);
        const float r = __builtin_amdgcn_rsqf(ss * (1.0f / 1024.0f) + 1e-6f);
        if (OUT_MODE == 2 || OUT_MODE == 3) { f32x4 y[4]; float am = 0.f; unsigned char* d8 = (OUT_MODE == 3) ? dst8 : (unsigned char*)dst;
#pragma unroll
            for (int q = 0; q < 4; ++q) { y[q] = v[q] * r * gv[q]; am = fmaxf(am, fmaxf(fmaxf(fabsf(y[q][0]), fabsf(y[q][1])), fmaxf(fabsf(y[q][2]), fabsf(y[q][3])))); }
            am = wave_max(am); const float inv = am > 0.f ? 127.0f / am : 0.f;
#pragma unroll
            for (int q = 0; q < 4; ++q) { *(unsigned*)(d8 + (size_t)row * DM + 256 * q + 4 * lane) = pack_i8x4(y[q][0] * inv, y[q][1] * inv, y[q][2] * inv, y[q][3] * inv);
                if (OUT_MODE == 3) { u32x2 w; w.x = cvt_pk_bf16(y[q][0], y[q][1]); w.y = cvt_pk_bf16(y[q][2], y[q][3]); *(u32x2*)((bf16_t*)dst + (size_t)row * DM + 256 * q + 4 * lane) = w; } }
            if (lane == 0) hsc[row] = am * (1.0f / 127.0f);
        } else {
#pragma unroll
        for (int q = 0; q < 4; ++q) { const f32x4 y = v[q] * r * gv[q];
            if (OUT_MODE == 1) { u32x2 w; w.x = cvt_pk_bf16(y[0], y[1]); w.y = cvt_pk_bf16(y[2], y[3]); *(u32x2*)((bf16_t*)dst + (size_t)row * DM + 256 * q + 4 * lane) = w; }
            else *(f32x4*)((float*)dst + (size_t)row * DM + 256 * q + 4 * lane) = y; }
        }
    }
}

__device__ __forceinline__ void tile_write_out(LAS float* tile, bf16_t* dst, int ld_dst, int n0, int k0) {
    const int tid = opaque_tid(), n = tid >> 3, ks = tid & 7;
    float v[8];
#pragma unroll
    for (int e = 0; e < 8; ++e) v[e] = tile[(8 * ks + e) * 65 + n];
    u32x4 w; w.x = cvt_pk_bf16(v[0], v[1]); w.y = cvt_pk_bf16(v[2], v[3]); w.z = cvt_pk_bf16(v[4], v[5]); w.w = cvt_pk_bf16(v[6], v[7]);
    *(u32x4*)(dst + (size_t)(n0 + n) * ld_dst + k0 + 8 * ks) = w;
}
__device__ __forceinline__ void transpose_tile(LAS float* tile, const float* src, int ld_src, int src_col0, int k0, bf16_t* dst, int ld_dst, int n0) {
    const int tid = opaque_tid();
#pragma unroll
    for (int q = 0; q < 2; ++q) { const int row = (tid >> 4) + 32 * q, c4 = (tid & 15) * 4;
        const f32x4 v = *(const f32x4*)(src + (size_t)(k0 + row) * ld_src + src_col0 + c4);
        tile[row * 65 + c4] = v[0]; tile[row * 65 + c4 + 1] = v[1]; tile[row * 65 + c4 + 2] = v[2]; tile[row * 65 + c4 + 3] = v[3]; }
    WG_SYNC();
    tile_write_out(tile, dst, ld_dst, n0, k0);
    WG_SYNC();
}
__device__ __forceinline__ void prologue_phase(const Params& p, LAS unsigned char* L, int G, int c) {
    const int tid = opaque_tid(), lane = tid & 63, wid = tid >> 6;
    LAS float* tile = (LAS float*)L;
    unsigned char* ws = p.ws;
    for (int it = c; it < 768; it += G) { const bool isq = it >= 640;
        const int l = isq ? (it - 640) / 64 : it / 320, n0 = isq ? ((it - 640) % 64) * 32 : (it % 320) * 32; const int kg = tid >> 3, n4 = (tid & 7) * 4;
        const int ldw = isq ? 2048 : IN_W;
        const float* src = isq ? p.peer_wq + (size_t)l * 1024 * 2048 : p.w_in + (size_t)l * 1024 * IN_W; unsigned char* dst = isq ? ws + WS_WQ + (size_t)l * 2048 * 1024 : ws + WS_WIN + (size_t)l * NP * 1024;
        float* scd = isq ? (float*)(ws + WS_WQSC) + (size_t)l * 2048 : (float*)(ws + WS_WSC) + (size_t)l * NP;
        f32x4 v[16];
        if (!isq && n0 >= C_Z && n0 < C_G) {
            const float* aw = p.alpha_w + (size_t)l * 16 * 256 + (n0 - C_Z) + n4;
            f32x4 a[16];
#pragma unroll
            for (int r2 = 0; r2 < 16; ++r2) a[r2] = *(const f32x4*)(aw + r2 * 256);
#pragma unroll
            for (int r = 0; r < 16; ++r) { const float* wr = src + (size_t)(16 * kg + r) * IN_W + 6400; f32x4 acc = (f32x4){0.f, 0.f, 0.f, 0.f};
#pragma unroll
                for (int q = 0; q < 4; ++q) { const f32x4 wv = *(const f32x4*)(wr + 4 * q); acc += a[4 * q] * wv[0]; acc += a[4 * q + 1] * wv[1]; acc += a[4 * q + 2] * wv[2]; acc += a[4 * q + 3] * wv[3]; }
                v[r] = acc; }
        } else { const int sc0 = isq ? n0 : ((n0 < C_RC) ? n0 : (n0 < C_Z ? n0 + 16 : n0 - 240));
#pragma unroll
            for (int r = 0; r < 16; ++r) v[r] = *(const f32x4*)(src + (size_t)(16 * kg + r) * ldw + sc0 + n4); }
        f32x4 am = (f32x4){0.f, 0.f, 0.f, 0.f};
#pragma unroll
        for (int r = 0; r < 16; ++r) { am[0] = fmaxf(am[0], fabsf(v[r][0])); am[1] = fmaxf(am[1], fabsf(v[r][1])); am[2] = fmaxf(am[2], fabsf(v[r][2])); am[3] = fmaxf(am[3], fabsf(v[r][3])); }
#pragma unroll
        for (int o = 8; o <= 32; o <<= 1) { am[0] = fmaxf(am[0], __shfl_xor(am[0], o)); am[1] = fmaxf(am[1], __shfl_xor(am[1], o)); am[2] = fmaxf(am[2], __shfl_xor(am[2], o)); am[3] = fmaxf(am[3], __shfl_xor(am[3], o)); }
        if (lane < 8) *(LAS f32x4*)(tile + wid * 32 + 4 * lane) = am;
        WG_SYNC();
        f32x4 amx = (f32x4){0.f, 0.f, 0.f, 0.f};
#pragma unroll
        for (int w2 = 0; w2 < 8; ++w2) { const f32x4 t = *(const LAS f32x4*)(tile + w2 * 32 + n4); amx[0] = fmaxf(amx[0], t[0]); amx[1] = fmaxf(amx[1], t[1]); amx[2] = fmaxf(amx[2], t[2]); amx[3] = fmaxf(amx[3], t[3]); }
        float inv[4];
#pragma unroll
        for (int q = 0; q < 4; ++q) inv[q] = amx[q] > 0.f ? 127.0f / amx[q] : 0.f;
        if (kg == 0) *(f32x4*)(scd + n0 + n4) = amx * (1.0f / 127.0f);
#pragma unroll
        for (int q = 0; q < 4; ++q) { unsigned wd[4];
#pragma unroll
            for (int r4 = 0; r4 < 4; ++r4) wd[r4] = pack_i8x4(v[4 * r4][q] * inv[q], v[4 * r4 + 1][q] * inv[q], v[4 * r4 + 2][q] * inv[q], v[4 * r4 + 3][q] * inv[q]);
            u32x4 o; o.x = wd[0]; o.y = wd[1]; o.z = wd[2]; o.w = wd[3];
            *(u32x4*)(dst + (size_t)(n0 + n4 + q) * 1024 + 16 * kg) = o; }
        WG_SYNC();
    }
    for (int it = 5120 + c; it < 6400; it += G) {
        if (false) {
        } else if (it < 5888) { const int q = it - 5120, ln = q / 128, r = q % 128, nt = r / 8, kt = r % 8;
            transpose_tile(tile, p.w_branch + (size_t)ln * 512 * 1024, 1024, nt * 64, kt * 64, (bf16_t*)(ws + WS_WBR) + (size_t)ln * 1024 * 512, 512, nt * 64);
        } else if (it < 6400) { const int q = it - 5888, l = q / 256, r = q % 256, nt = r / 16, kt = r % 16;
            transpose_tile(tile, p.w_out + (size_t)l * 1024 * 1024, 1024, nt * 64, kt * 64, (bf16_t*)(ws + WS_WOUT) + (size_t)l * 1024 * 1024, 1024, nt * 64);
        } else { const int q = it - 6400, l = q / 512, r = q % 512, nt = r / 16, kt = r % 16;
            transpose_tile(tile, p.peer_wq + (size_t)l * 1024 * 2048, 2048, nt * 64, kt * 64, (bf16_t*)(ws + WS_WQ) + (size_t)l * 2048 * 1024, 1024, nt * 64); }
    }
    for (int i = (c * 512 + tid) * 8; i < 2 * 8 * 2 * 128 * 128; i += G * 512 * 8) {
        const f32x4 a = *(const f32x4*)(p.peer_keys + i), b = *(const f32x4*)(p.peer_keys + i + 4);
        u32x4 w; w.x = cvt_pk_bf16(a[0], a[1]); w.y = cvt_pk_bf16(a[2], a[3]); w.z = cvt_pk_bf16(b[0], b[1]); w.w = cvt_pk_bf16(b[2], b[3]);
        *(u32x4*)((bf16_t*)(ws + WS_KEYS) + i) = w; }
    for (int row0 = c * 8 + wid; row0 < 4 * NEXP; row0 += G * 8 * 2) {
        f32x4 vb[2][4];
#pragma unroll
        for (int b = 0; b < 2; ++b) { const int row = row0 + b * G * 8; const int rw = row < 4 * NEXP ? row : row0; const int tb = rw / (2 * NEXP), rem = rw % (2 * NEXP);
            const float* src = (tb ? p.peer_v : p.peer_u) + (size_t)rem * 1024 + 16 * lane;
#pragma unroll
            for (int q = 0; q < 4; ++q) vb[b][q] = *(const f32x4*)(src + 4 * q); }
#pragma unroll
        for (int b = 0; b < 2; ++b) { const int row = row0 + b * G * 8; if (row >= 4 * NEXP) break;
            const int tb = row / (2 * NEXP), rem = row % (2 * NEXP), l = rem / NEXP, e = rem % NEXP;
            f32x4 v[4]; float am = 0.f;
#pragma unroll
            for (int q = 0; q < 4; ++q) { v[q] = vb[b][q]; am = fmaxf(am, fmaxf(fmaxf(fabsf(v[q][0]), fabsf(v[q][1])), fmaxf(fabsf(v[q][2]), fabsf(v[q][3])))); }
            am = wave_max(am);
            const float qmax = tb ? 256.0f : 127.0f; const float inv = am > 0.f ? qmax / am : 0.f;
            u32x4 w; unsigned ww[4];
#pragma unroll
            for (int q = 0; q < 4; ++q) { if (tb) { int pk = __builtin_amdgcn_cvt_pk_fp8_f32(v[q][0] * inv, v[q][1] * inv, 0, false); pk = __builtin_amdgcn_cvt_pk_fp8_f32(v[q][2] * inv, v[q][3] * inv, pk, true); ww[q] = (unsigned)pk; }
                else ww[q] = pack_i8x4(v[q][0] * inv, v[q][1] * inv, v[q][2] * inv, v[q][3] * inv); }
            w.x = ww[0]; w.y = ww[1]; w.z = ww[2]; w.w = ww[3];
            unsigned char* dst = ws + (tb ? WS_V8 : WS_U8) + (((size_t)l * 8 + (lane >> 3)) * NEXP + e) * 128 + 16 * (lane & 7);
            *(u32x4*)dst = w;
            if (lane == 0) ((float*)(ws + (tb ? WS_VSC : WS_USC)))[l * NEXP + e] = am / qmax;
        }
    }
    for (int i = c * 512 + tid; i < 32 * 132; i += G * 512) { const int hh = i / 132, ds = i % 132; const int dil = hh < 16 ? 1 : (hh < 24 ? 4 : 16); const int d = ds * dil;
        int bucket = d;
        if (d >= 16) { bucket = 16 + (int)(log((double)d / 16.0) / log(128.0) * 16.0); if (bucket > 31) bucket = 31; }
        ((float*)(ws + WS_LUT))[i] = p.rel_bias[bucket * 32 + hh]; }
    rmsnorm_phase<2>(p.x, p.norm_mix, ws + WS_H, G, c, (float*)(ws + WS_HSC));
}

struct AttnUnit { int qcol, kcol, vcol, dil, maxd, lutrow, batch, r, blk, head; float sink; float* lse; };
__device__ __forceinline__ void attn_decode(const Params& p, int layer, bool groupB, int u, AttnUnit& a) {
    if (!groupB) { a.head = u & 7; const int rest = u >> 3; a.batch = rest >> 4; a.blk = rest & 15; a.r = 0; a.dil = 1; a.maxd = 127;
        a.qcol = C_QA + 64 * a.head; a.kcol = C_KA + 64 * (a.head >> 2); a.vcol = C_VA + 64 * (a.head >> 2); a.lutrow = a.head; a.sink = p.sinks[layer * 8 + a.head]; a.lse = nullptr; }
    else { const int g = u >> 10, uu = u & 1023; a.head = uu & 7; const int rest = uu >> 3; a.batch = rest >> 4; const int sb = rest & 15; a.dil = 1 << (2 * g); const int nblk = 16 >> (2 * g);
        a.r = sb / nblk; a.blk = sb % nblk; a.maxd = 128; const int base = C_B0 + 1536 * g;
        a.qcol = base + 64 * a.head; a.kcol = base + 512 + 64 * a.head; a.vcol = base + 1024 + 64 * a.head; a.lutrow = 8 + 8 * g + a.head; a.sink = -3.0e38f; a.lse = (float*)(p.ws + WS_LSE) + (size_t)g * T_TOK * 8; }
}
__device__ __forceinline__ void attn_issue(const bf16_t* P, const float* lutg, const AttnUnit& a, int tid, int w, int j, int g4, uint4 (&kreg)[4], uint4 (&vreg)[4], uint4 (&qreg)[2], float& lutv) {
    lutv = lutg[a.lutrow * 132 + (tid < 132 ? tid : 0)];
#pragma unroll
    for (int q = 0; q < 4; ++q) { const int piece = tid + 512 * q, row = piece >> 3, seg = piece & 7; const int sub = 128 * (a.blk - 1) + row;
        if (sub >= 0) { const size_t grow = (size_t)a.batch * SEQ + (size_t)sub * a.dil + a.r; kreg[q] = *(const uint4*)(P + pidx(grow, a.kcol + 8 * seg)); vreg[q] = *(const uint4*)(P + pidx(grow, a.vcol + 8 * seg)); }
        else { kreg[q] = make_uint4(0u, 0u, 0u, 0u); vreg[q] = make_uint4(0u, 0u, 0u, 0u); } }
    const size_t qrow = (size_t)a.batch * SEQ + (size_t)(128 * a.blk + 16 * w + j) * a.dil + a.r; const bf16_t* qp = P + pidx(qrow, a.qcol + 8 * g4);
    qreg[0] = *(const uint4*)qp; qreg[1] = *(const uint4*)(qp + 32);
}
__device__ __forceinline__ bf16x8 as_bf16x8(uint4 v) { union { uint4 u; bf16x8 b; } x; x.u = v; return x.b; }
__device__ __forceinline__ bf16x8 mk_bf16x8(unsigned a, unsigned b, unsigned c, unsigned d) { union { unsigned u[4]; bf16x8 v; } x; x.u[0] = a; x.u[1] = b; x.u[2] = c; x.u[3] = d; return x.v; }

typedef short v4s_t __attribute__((ext_vector_type(4)));
__device__ __forceinline__ u32x2 lds_tr16(const LAS unsigned char* p) { return __builtin_bit_cast(u32x2, __builtin_amdgcn_ds_read_tr16_b64_v4i16((LAS v4s_t*)p)); }
__device__ __forceinline__ u32x2 lds_tr16_v(const LAS unsigned char* p) { u32x2 r; asm volatile("ds_read_b64_tr_b16 %0, %1" : "=v"(r) : "v"((unsigned)(size_t)p) : "memory"); return r; }
__device__ __forceinline__ void attn_phase(const Params& p, LAS unsigned char* L, int layer, bool groupB, int G, int c, bool dry = false) {
    const int tid = opaque_tid(), lane = tid & 63, w = __builtin_amdgcn_readfirstlane(tid >> 6), j = lane & 15, g4 = lane >> 4;
    bf16_t* P = (bf16_t*)(p.ws + WS_P);
    const float* lutg = (const float*)(p.ws + WS_LUT);
    LAS unsigned char* Ks = L; LAS unsigned char* Vs = L + 36864; LAS float* lutL = (LAS float*)(L + 36864 + 40960);
    const int nunits = groupB ? 3072 : 1024;
    int u = c; if (u >= nunits) return;
    uint4 kreg[4], vreg[4], qreg[2]; float lutv; AttnUnit cu, nu;
    attn_decode(p, layer, groupB, u, cu); attn_issue(P, lutg, cu, tid, w, j, g4, kreg, vreg, qreg, lutv);
    const int trq = (lane & 15) >> 2, trp = lane & 3;
    const float C1 = 0.125f * 1.4426950408889634f;
    for (;;) {
#pragma unroll
        for (int q = 0; q < 4; ++q) { const int piece = tid + 512 * q, row = piece >> 3, seg = piece & 7;
            *(LAS u32x4*)(Ks + row * 144 + seg * 16) = (u32x4){kreg[q].x, kreg[q].y, kreg[q].z, kreg[q].w};
            *(LAS u32x4*)(Vs + row * 160 + seg * 16) = (u32x4){vreg[q].x, vreg[q].y, vreg[q].z, vreg[q].w}; }
        if (tid < 132) lutL[tid] = lutv * 1.4426950408889634f;
        const bf16x8 qf0 = as_bf16x8(qreg[0]), qf1 = as_bf16x8(qreg[1]);
        WG_SYNC();
        const int un = u + G; const bool has_next = un < nunits;
        if (has_next) { attn_decode(p, layer, groupB, un, nu); attn_issue(P, lutg, nu, tid, w, j, g4, kreg, vreg, qreg, lutv); }
#define LDS_WAIT() __builtin_amdgcn_sched_barrier(0)
        const LAS float* lutp = lutL + (128 + j - 4 * g4);
        const int dq = j - 4 * g4;
        float biasv[9][4];
#pragma unroll
        for (int kt = 0; kt < 9; ++kt)
#pragma unroll
            for (int e = 0; e < 4; ++e) biasv[kt][e] = (kt == 8) ? lutL[(dq - e) < 0 ? 0 : (dq - e)] : lutp[-16 * kt - e];
        bf16x8 kf[2][3][2];
        const LAS unsigned char* kb0 = Ks + (16 * w + j) * 144 + 16 * g4;
#pragma unroll
        for (int t3 = 0; t3 < 3; ++t3) { kf[0][t3][0] = *(const LAS bf16x8*)(kb0 + t3 * 16 * 144); kf[0][t3][1] = *(const LAS bf16x8*)(kb0 + t3 * 16 * 144 + 64); }
        f32x4 sacc[9];
#pragma unroll
        for (int gq = 0; gq < 3; ++gq) { LDS_WAIT();
            if (gq < 2) {
#pragma unroll
                for (int t3 = 0; t3 < 3; ++t3) { kf[(gq + 1) & 1][t3][0] = *(const LAS bf16x8*)(kb0 + (3 * (gq + 1) + t3) * 16 * 144); kf[(gq + 1) & 1][t3][1] = *(const LAS bf16x8*)(kb0 + (3 * (gq + 1) + t3) * 16 * 144 + 64); } }
#pragma unroll
            for (int t3 = 0; t3 < 3; ++t3) { const int kt = 3 * gq + t3; sacc[kt] = (f32x4){0.f, 0.f, 0.f, 0.f};
                sacc[kt] = __builtin_amdgcn_mfma_f32_16x16x32_bf16(kf[gq & 1][t3][0], qf0, sacc[kt], 0, 0, 0);
                sacc[kt] = __builtin_amdgcn_mfma_f32_16x16x32_bf16(kf[gq & 1][t3][1], qf1, sacc[kt], 0, 0, 0); } }
        const float sinkl = cu.sink * 1.4426950408889634f;
        float mx = -3.0e38f;
#pragma unroll
        for (int kt = 0; kt < 9; ++kt) { const bool tile_ok = (cu.blk > 0) || (w + kt >= 8);
#pragma unroll
            for (int e = 0; e < 4; ++e) { bool valid = tile_ok;
                if (kt == 0) valid = valid && (128 + dq - e <= cu.maxd);
                if (kt == 8) valid = valid && (dq - e >= 0);
                const float sv = valid ? sacc[kt][e] * C1 + biasv[kt][e] : -1.0e30f;
                sacc[kt][e] = sv; mx = fmaxf(mx, sv); } }
        mx = fmaxf(mx, __shfl_xor(mx, 16)); mx = fmaxf(mx, __shfl_xor(mx, 32)); mx = fmaxf(mx, sinkl);
        float sum = 0.f;
#pragma unroll
        for (int kt = 0; kt < 9; ++kt)
#pragma unroll
            for (int e = 0; e < 4; ++e) { const float pv = __builtin_amdgcn_exp2f(sacc[kt][e] - mx); sacc[kt][e] = pv; sum += pv; }
        sum += __shfl_xor(sum, 16); sum += __shfl_xor(sum, 32);
        const float denom = sum + __builtin_amdgcn_exp2f(sinkl - mx);
        bf16x8 pb[5];
#pragma unroll
        for (int cc = 0; cc < 5; ++cc) { const unsigned a0 = cvt_pk_bf16(sacc[2 * cc][0], sacc[2 * cc][1]), a1 = cvt_pk_bf16(sacc[2 * cc][2], sacc[2 * cc][3]);
            unsigned b0 = 0u, b1 = 0u; if (cc < 4) { b0 = cvt_pk_bf16(sacc[2 * cc + 1][0], sacc[2 * cc + 1][1]); b1 = cvt_pk_bf16(sacc[2 * cc + 1][2], sacc[2 * cc + 1][3]); }
            pb[cc] = mk_bf16x8(a0, a1, b0, b1); }
        f32x4 oacc[4];
        const LAS unsigned char* vbase = Vs + (16 * w + 4 * g4 + trq) * 160 + 8 * trp;
        u32x2 vf[2][5][2];
#pragma unroll
        for (int cc = 0; cc < 5; ++cc) { vf[0][cc][0] = lds_tr16(vbase + (32 * cc) * 160); vf[0][cc][1] = (cc < 4) ? lds_tr16(vbase + (32 * cc + 16) * 160) : (u32x2){0u, 0u}; }
#pragma unroll
        for (int dt = 0; dt < 4; ++dt) { LDS_WAIT();
            if (dt < 3) {
#pragma unroll
                for (int cc = 0; cc < 5; ++cc) { vf[(dt + 1) & 1][cc][0] = lds_tr16(vbase + (32 * cc) * 160 + 32 * (dt + 1)); vf[(dt + 1) & 1][cc][1] = (cc < 4) ? lds_tr16(vbase + (32 * cc + 16) * 160 + 32 * (dt + 1)) : (u32x2){0u, 0u}; } }
            oacc[dt] = (f32x4){0.f, 0.f, 0.f, 0.f};
#pragma unroll
            for (int cc = 0; cc < 5; ++cc) oacc[dt] = __builtin_amdgcn_mfma_f32_16x16x32_bf16(mk_bf16x8(vf[dt & 1][cc][0].x, vf[dt & 1][cc][0].y, vf[dt & 1][cc][1].x, vf[dt & 1][cc][1].y), pb[cc], oacc[dt], 0, 0, 0); }
#undef LDS_WAIT
        const float inv = __builtin_amdgcn_rcpf(denom);
        const size_t qrow = (size_t)cu.batch * SEQ + (size_t)(128 * cu.blk + 16 * w + j) * cu.dil + cu.r;
        bf16_t* op = P + pidx(qrow, cu.qcol + 4 * g4);
#pragma unroll
        for (int dt = 0; dt < 4; ++dt) { u32x2 o; o.x = cvt_pk_bf16(oacc[dt][0] * inv, oacc[dt][1] * inv); o.y = cvt_pk_bf16(oacc[dt][2] * inv, oacc[dt][3] * inv); if (!dry) *(u32x2*)(op + 16 * dt) = o; }
        if (cu.lse != nullptr && g4 == 0 && !dry) cu.lse[qrow * 8 + cu.head] = (mx + __builtin_amdgcn_logf(denom)) * 0.6931471805599453f;
        WG_SYNC();
        if (!has_next) break;
        cu = nu; u = un;
    }
}
__device__ __forceinline__ void combine_phase(const Params& p, int G, int c, bool dry = false) {
    bf16_t* P = (bf16_t*)(p.ws + WS_P); const float* LSE = (const float*)(p.ws + WS_LSE);
    const int tid = opaque_tid();
    for (int i = c * 512 + tid; i < T_TOK * 64; i += G * 512) { const int seg = i & 7, h = (i >> 3) & 7, t = i >> 6;
        const float l0 = LSE[(size_t)t * 8 + h], l1 = LSE[(size_t)T_TOK * 8 + (size_t)t * 8 + h], l2 = LSE[(size_t)2 * T_TOK * 8 + (size_t)t * 8 + h];
        const float m = fmaxf(l0, fmaxf(l1, l2)); float w0 = fexp(l0 - m), w1 = fexp(l1 - m), w2 = fexp(l2 - m); const float inv = 1.0f / (w0 + w1 + w2); w0 *= inv; w1 *= inv; w2 *= inv;
        bf16_t* b = P + pidx((size_t)t, C_B0 + 64 * h + 8 * seg);
        const u32x4 a0 = *(const u32x4*)b, a1 = *(const u32x4*)(P + pidx((size_t)t, C_B0 + 1536 + 64 * h + 8 * seg)), a2 = *(const u32x4*)(P + pidx((size_t)t, C_B0 + 3072 + 64 * h + 8 * seg));
        u32x4 o;
        o.x = cvt_pk_bf16(w0 * bflo(a0.x) + w1 * bflo(a1.x) + w2 * bflo(a2.x), w0 * bfhi(a0.x) + w1 * bfhi(a1.x) + w2 * bfhi(a2.x));
        o.y = cvt_pk_bf16(w0 * bflo(a0.y) + w1 * bflo(a1.y) + w2 * bflo(a2.y), w0 * bfhi(a0.y) + w1 * bfhi(a1.y) + w2 * bfhi(a2.y));
        o.z = cvt_pk_bf16(w0 * bflo(a0.z) + w1 * bflo(a1.z) + w2 * bflo(a2.z), w0 * bfhi(a0.z) + w1 * bfhi(a1.z) + w2 * bfhi(a2.z));
        o.w = cvt_pk_bf16(w0 * bflo(a0.w) + w1 * bflo(a1.w) + w2 * bflo(a2.w), w0 * bfhi(a0.w) + w1 * bfhi(a1.w) + w2 * bfhi(a2.w));
        if (!dry) *(u32x4*)b = o; }
}

__device__ __forceinline__ void gla_cum(const LAS unsigned char* LA, int c, int s, LAS float* tot, float (&cum)[8], float& last) {
    float run = 0.f;
#pragma unroll
    for (int jr = 0; jr < 8; ++jr) { run += bf2f(*(const LAS unsigned short*)(LA + (8 * s + jr) * 128 + 2 * c)); cum[jr] = run; }
    tot[s * 64 + c] = run;
    WG_SYNC();
    float off = 0.f, all = 0.f;
#pragma unroll
    for (int s2 = 0; s2 < 8; ++s2) { const float v = tot[s2 * 64 + c]; all += v; off += (s2 < s) ? v : 0.f; }
#pragma unroll
    for (int jr = 0; jr < 8; ++jr) cum[jr] += off;
    last = all;
}
__device__ __forceinline__ u32x4 to_u32x4(uint4 v) { return (u32x4){v.x, v.y, v.z, v.w}; }
__device__ __forceinline__ void gla_a_phase(const Params& p, LAS unsigned char* L, int G, int c) {
    const int tid = opaque_tid(), lane = tid & 63, w = __builtin_amdgcn_readfirstlane(tid >> 6), j = lane & 15, g4 = lane >> 4, cc = tid & 63, s = tid >> 6;
    const int trq = (lane & 15) >> 2, trp = lane & 3;
    const bf16_t* P = (const bf16_t*)(p.ws + WS_P); float* KV = (float*)(p.ws + WS_H); float* DEC = (float*)(p.ws + WS_DECAY);
    LAS unsigned char* LA = L; LAS unsigned char* KT = L + 8192; LAS unsigned char* VS = L + 16384; LAS unsigned char* KeT = L + 34816; LAS float* tot = (LAS float*)(L + 44032);
    int u = c; if (u >= 1024) return;
    uint4 rla, rk, rv[2];
#define GLA_A_ISSUE(uu) do { const int h_ = (uu) & 3, n_ = ((uu) >> 2) & 31, b_ = (uu) >> 7; const size_t tr_ = (size_t)b_ * SEQ + 64 * n_; \
        rla = *(const uint4*)(P + pidx(tr_ + (tid >> 3), C_Z + 64 * h_ + 8 * (tid & 7))); rk = *(const uint4*)(P + pidx(tr_ + (tid >> 3), C_KC + 64 * h_ + 8 * (tid & 7))); \
        _Pragma("unroll") for (int q_ = 0; q_ < 2; ++q_) { const int pc_ = tid + 512 * q_; rv[q_] = *(const uint4*)(P + pidx(tr_ + (pc_ >> 4), C_VC + 128 * h_ + 8 * (pc_ & 15))); } } while (0)
    GLA_A_ISSUE(u);
    for (;;) { const int h = u & 3, n = (u >> 2) & 31, b = u >> 7; const int base = (b * 32 + n) * 4 + h;
        *(LAS u32x4*)(LA + (tid >> 3) * 128 + (tid & 7) * 16) = to_u32x4(rla); *(LAS u32x4*)(KT + (tid >> 3) * 128 + (tid & 7) * 16) = to_u32x4(rk);
#pragma unroll
        for (int q = 0; q < 2; ++q) { const int pc = tid + 512 * q; *(LAS u32x4*)(VS + (pc >> 4) * 288 + (pc & 15) * 16) = to_u32x4(rv[q]); }
        WG_SYNC();
        const int un = u + G; const bool has_next = un < 1024;
        if (has_next) GLA_A_ISSUE(un);
        float cum[8], last; gla_cum(LA, cc, s, tot, cum, last);
        float ke[8];
#pragma unroll
        for (int jr = 0; jr < 8; ++jr) ke[jr] = bf2f(*(const LAS unsigned short*)(KT + (8 * s + jr) * 128 + 2 * cc)) * fexp(last - cum[jr]);
        u32x4 kw; kw.x = cvt_pk_bf16(ke[0], ke[1]); kw.y = cvt_pk_bf16(ke[2], ke[3]); kw.z = cvt_pk_bf16(ke[4], ke[5]); kw.w = cvt_pk_bf16(ke[6], ke[7]);
        *(LAS u32x4*)(KeT + cc * 144 + 16 * s) = kw;
        if (s == 0) DEC[base * 64 + cc] = fexp(last);
        WG_SYNC();
        f32x4 acc[4];
#pragma unroll
        for (int ct = 0; ct < 4; ++ct) acc[ct] = (f32x4){0.f, 0.f, 0.f, 0.f};
#pragma unroll
        for (int k2 = 0; k2 < 2; ++k2) { const LAS unsigned char* vb = VS + (32 * k2 + 8 * g4 + trq) * 288 + (16 * w + 4 * trp) * 2;
            const u32x2 lo = lds_tr16(vb), hi = lds_tr16(vb + 4 * 288); const bf16x8 af = mk_bf16x8(lo.x, lo.y, hi.x, hi.y);
#pragma unroll
            for (int ct = 0; ct < 4; ++ct) acc[ct] = __builtin_amdgcn_mfma_f32_16x16x32_bf16(af, *(const LAS bf16x8*)(KeT + (16 * ct + j) * 144 + (8 * g4 + 32 * k2) * 2), acc[ct], 0, 0, 0); }
#pragma unroll
        for (int ct = 0; ct < 4; ++ct)
#pragma unroll
            for (int e = 0; e < 4; ++e) KV[((size_t)base * 128 + 16 * w + 4 * g4 + e) * 64 + 16 * ct + j] = acc[ct][e];
        WG_SYNC();
        if (!has_next) break;
        u = un;
    }
#undef GLA_A_ISSUE
}
__device__ __forceinline__ void gla_scan_phase(const Params& p, int G, int c) {
    const float* KV = (const float*)(p.ws + WS_H); const float* DEC = (const float*)(p.ws + WS_DECAY); bf16_t* SP = (bf16_t*)(p.ws + WS_SPREV);
    const int tid = opaque_tid();
    for (int eid = c * 512 + tid; eid < 262144; eid += G * 512) { const int cc = eid & 63, v = (eid >> 6) & 127, h = (eid >> 13) & 3, b = eid >> 15;
        float state = 0.f;
        for (int n0 = 0; n0 < 32; n0 += 8) {
            float kvv[8], dcv[8];
#pragma unroll
            for (int q = 0; q < 8; ++q) { const int base = (b * 32 + n0 + q) * 4 + h; kvv[q] = KV[((size_t)base * 128 + v) * 64 + cc]; dcv[q] = DEC[base * 64 + cc]; }
#pragma unroll
            for (int q = 0; q < 8; ++q) { const int base = (b * 32 + n0 + q) * 4 + h; SP[((size_t)base * 128 + v) * 64 + cc] = (bf16_t)(cvt_pk_bf16(state, 0.f) & 0xffffu); state = state * dcv[q] + kvv[q]; } } }
}
__device__ __forceinline__ void gla_c_phase(const Params& p, LAS unsigned char* L, int layer, int G, int c, bool dry = false) {
    const int tid = opaque_tid(), lane = tid & 63, w = __builtin_amdgcn_readfirstlane(tid >> 6), j = lane & 15, g4 = lane >> 4, cc = tid & 63, s = tid >> 6;
    const int trq = (lane & 15) >> 2, trp = lane & 3;
    bf16_t* P = (bf16_t*)(p.ws + WS_P); const bf16_t* SP = (const bf16_t*)(p.ws + WS_SPREV);
    LAS unsigned char* LA = L; LAS unsigned char* KT = L + 8192; LAS unsigned char* QT = L + 16384; LAS unsigned char* VS = L + 24576;
    LAS unsigned char* QD = L + 43008; LAS unsigned char* KI = L + 52224; LAS float* tot = (LAS float*)(L + 61440); LAS float* ssb = (LAS float*)(L + 63488);
    const int tt = w & 3, vh = w >> 2;
    int u = c; if (u >= 1024) return;
    f32x4 hnv[4];
#pragma unroll
    for (int vt = 0; vt < 4; ++vt) hnv[vt] = *(const f32x4*)(p.head_norm + layer * 128 + 16 * (4 * vh + vt) + 4 * g4);
    uint4 rla, rk, rq, rv[2];
#define GLA_C_ISSUE(uu) do { const int h_ = (uu) & 3, n_ = ((uu) >> 2) & 31, b_ = (uu) >> 7; const size_t tr_ = (size_t)b_ * SEQ + 64 * n_; \
        rla = *(const uint4*)(P + pidx(tr_ + (tid >> 3), C_Z + 64 * h_ + 8 * (tid & 7))); rk = *(const uint4*)(P + pidx(tr_ + (tid >> 3), C_KC + 64 * h_ + 8 * (tid & 7))); rq = *(const uint4*)(P + pidx(tr_ + (tid >> 3), C_QC + 64 * h_ + 8 * (tid & 7))); \
        _Pragma("unroll") for (int q_ = 0; q_ < 2; ++q_) { const int pc_ = tid + 512 * q_; rv[q_] = *(const uint4*)(P + pidx(tr_ + (pc_ >> 4), C_VC + 128 * h_ + 8 * (pc_ & 15))); } } while (0)
    GLA_C_ISSUE(u);
    for (;;) { const int h = u & 3, n = (u >> 2) & 31, b = u >> 7; const size_t trow0 = (size_t)b * SEQ + 64 * n; const int base = (b * 32 + n) * 4 + h;
        *(LAS u32x4*)(LA + (tid >> 3) * 128 + (tid & 7) * 16) = to_u32x4(rla); *(LAS u32x4*)(KT + (tid >> 3) * 128 + (tid & 7) * 16) = to_u32x4(rk); *(LAS u32x4*)(QT + (tid >> 3) * 128 + (tid & 7) * 16) = to_u32x4(rq);
#pragma unroll
        for (int q = 0; q < 2; ++q) { const int pc = tid + 512 * q; *(LAS u32x4*)(VS + (pc >> 4) * 288 + (pc & 15) * 16) = to_u32x4(rv[q]); }
        WG_SYNC();
        bf16x8 spf[4][2]; u32x2 rr[4]; const size_t orw = trow0 + 16 * tt + j;
#pragma unroll
        for (int vt = 0; vt < 4; ++vt) { const int V = 4 * vh + vt;
#pragma unroll
            for (int k2 = 0; k2 < 2; ++k2) spf[vt][k2] = *(const bf16x8*)(SP + ((size_t)base * 128 + 16 * V + j) * 64 + 8 * g4 + 32 * k2);
            rr[vt] = *(const u32x2*)(P + pidx(orw, C_RC + 128 * h + 16 * V + 4 * g4)); }
        const int un = u + G; const bool has_next = un < 1024;
        if (has_next) GLA_C_ISSUE(un);
        float cum[8], last; gla_cum(LA, cc, s, tot, cum, last);
#pragma unroll
        for (int jr = 0; jr < 8; ++jr) { const int ro = (8 * s + jr) * 128 + 2 * cc;
            const float qd = bf2f(*(const LAS unsigned short*)(QT + ro)) * 0.125f * fexp(cum[jr]), ki = bf2f(*(const LAS unsigned short*)(KT + ro)) * fexp(-cum[jr]);
            *(LAS unsigned short*)(QD + (8 * s + jr) * 144 + 2 * cc) = (unsigned short)(cvt_pk_bf16(qd, 0.f) & 0xffffu);
            *(LAS unsigned short*)(KI + (8 * s + jr) * 144 + 2 * cc) = (unsigned short)(cvt_pk_bf16(ki, 0.f) & 0xffffu); }
        WG_SYNC();
        bf16x8 qdf[2];
#pragma unroll
        for (int k2 = 0; k2 < 2; ++k2) qdf[k2] = *(const LAS bf16x8*)(QD + (16 * tt + j) * 144 + (8 * g4 + 32 * k2) * 2);
        f32x4 sa[4];
#pragma unroll
        for (int st = 0; st < 4; ++st) { sa[st] = (f32x4){0.f, 0.f, 0.f, 0.f};
            if (st <= tt) {
#pragma unroll
                for (int k2 = 0; k2 < 2; ++k2) sa[st] = __builtin_amdgcn_mfma_f32_16x16x32_bf16(*(const LAS bf16x8*)(KI + (16 * st + j) * 144 + (8 * g4 + 32 * k2) * 2), qdf[k2], sa[st], 0, 0, 0);
                if (st == tt) {
#pragma unroll
                    for (int e = 0; e < 4; ++e) if (4 * g4 + e > j) sa[st][e] = 0.f; } } }
        bf16x8 pb[2];
#pragma unroll
        for (int c2 = 0; c2 < 2; ++c2) pb[c2] = mk_bf16x8(cvt_pk_bf16(sa[2 * c2][0], sa[2 * c2][1]), cvt_pk_bf16(sa[2 * c2][2], sa[2 * c2][3]), cvt_pk_bf16(sa[2 * c2 + 1][0], sa[2 * c2 + 1][1]), cvt_pk_bf16(sa[2 * c2 + 1][2], sa[2 * c2 + 1][3]));
        f32x4 oacc[4]; float ss = 0.f;
#pragma unroll
        for (int vt = 0; vt < 4; ++vt) { const int V = 4 * vh + vt; oacc[vt] = (f32x4){0.f, 0.f, 0.f, 0.f};
#pragma unroll
            for (int c2 = 0; c2 < 2; ++c2) { const LAS unsigned char* vb = VS + (32 * c2 + 4 * g4 + trq) * 288 + (16 * V + 4 * trp) * 2; const u32x2 lo = lds_tr16(vb), hi = lds_tr16(vb + 16 * 288);
                oacc[vt] = __builtin_amdgcn_mfma_f32_16x16x32_bf16(mk_bf16x8(lo.x, lo.y, hi.x, hi.y), pb[c2], oacc[vt], 0, 0, 0); }
#pragma unroll
            for (int k2 = 0; k2 < 2; ++k2) oacc[vt] = __builtin_amdgcn_mfma_f32_16x16x32_bf16(spf[vt][k2], qdf[k2], oacc[vt], 0, 0, 0);
            ss += oacc[vt][0] * oacc[vt][0] + oacc[vt][1] * oacc[vt][1] + oacc[vt][2] * oacc[vt][2] + oacc[vt][3] * oacc[vt][3]; }
        ss += __shfl_xor(ss, 16); ss += __shfl_xor(ss, 32);
        if (g4 == 0) ssb[vh * 64 + 16 * tt + j] = ss;
        WG_SYNC();
        const float rstd = __builtin_amdgcn_rsqf((ssb[16 * tt + j] + ssb[64 + 16 * tt + j]) * (1.0f / 128.0f) + 1e-6f);
#pragma unroll
        for (int vt = 0; vt < 4; ++vt) { const int v0 = 16 * (4 * vh + vt) + 4 * g4; const f32x4 hn = hnv[vt];
            const float r0 = bflo(rr[vt].x), r1 = bfhi(rr[vt].x), r2 = bflo(rr[vt].y), r3 = bfhi(rr[vt].y);
            u32x2 o; o.x = cvt_pk_bf16(oacc[vt][0] * rstd * hn[0] * r0 * fsigmoid(r0), oacc[vt][1] * rstd * hn[1] * r1 * fsigmoid(r1));
            o.y = cvt_pk_bf16(oacc[vt][2] * rstd * hn[2] * r2 * fsigmoid(r2), oacc[vt][3] * rstd * hn[3] * r3 * fsigmoid(r3));
            if (!dry) *(u32x2*)(P + pidx(orw, C_VC + 128 * h + v0)) = o; }
        WG_SYNC();
        if (!has_next) break;
        u = un;
    }
#undef GLA_C_ISSUE
}

__device__ __forceinline__ int sort_key(float f) { const int u = __float_as_int(f); return u ^ ((u >> 31) & 0x7fffffff); }
__device__ __forceinline__ int med3i(int a, int b, int c) { return max(min(a, b), min(max(a, b), c)); }
__device__ __forceinline__ void topk_insert(int (&v)[16], int x) {
#pragma unroll
    for (int i = 15; i >= 1; --i) v[i] = med3i(v[i - 1], x, v[i]);
    v[0] = max(v[0], x);
}
__device__ __forceinline__ float key_val(int k, int mask) { const int kk = k & ~mask; return __int_as_float(kk ^ ((kk >> 31) & 0x7fffffff)); }
__device__ __forceinline__ void topk_merge16(int (&v)[16], int xm) {
    int t[16];
#pragma unroll
    for (int i = 0; i < 16; ++i) t[i] = max(v[i], __shfl_xor(v[15 - i], xm));
#pragma unroll
    for (int s = 8; s >= 1; s >>= 1)
#pragma unroll
        for (int i = 0; i < 16; ++i) if ((i & s) == 0) { const int hi = max(t[i], t[i + s]), lo = min(t[i], t[i + s]); t[i] = hi; t[i + s] = lo; }
#pragma unroll
    for (int i = 0; i < 16; ++i) v[i] = t[i];
}
__device__ __forceinline__ void peer_topk_phase(const Params& p, LAS unsigned char* L, int layer, int G, int c) {
    const int tid = opaque_tid(), lane = tid & 63, w = __builtin_amdgcn_readfirstlane(tid >> 6), j = lane & 15, g4 = lane >> 4;
    const bf16_t* QY = (const bf16_t*)(p.ws + WS_QY); const bf16_t* KEYS = (const bf16_t*)(p.ws + WS_KEYS); unsigned* IDXW = (unsigned*)(p.ws + WS_IDX); float* GATE = (float*)(p.ws + WS_GATE);
    LAS unsigned char* KL = L; LAS int* TK = (LAS int*)(L + 69632) + (w * 16 + j) * 32;
    int cur_h = -1;
    for (int u = c; u < 1024; u += G) { const int h = u & 7, tb = u >> 3;
        if (h != cur_h) { WG_SYNC();
#pragma unroll
            for (int q = 0; q < 8; ++q) { const int piece = tid + 512 * q, row = piece >> 4, seg = piece & 15;
                *(LAS u32x4*)(KL + row * 272 + seg * 16) = *(const u32x4*)(KEYS + ((size_t)(layer * 8 + h) * 256 + row) * 128 + 8 * seg); }
            WG_SYNC(); cur_h = h; }
        const size_t tok = (size_t)128 * tb + 16 * w + j;
        int K1[16], K2[16];
#pragma unroll
        for (int pp = 0; pp < 2; ++pp) {
            bf16x8 bq[4];
#pragma unroll
            for (int kc = 0; kc < 4; ++kc) bq[kc] = *(const bf16x8*)(QY + tok * 2048 + h * 256 + pp * 128 + 8 * g4 + 32 * kc);
            int v[16];
#pragma unroll
            for (int i = 0; i < 16; ++i) v[i] = (int)0x80000000;
#pragma unroll
            for (int nt = 0; nt < 8; ++nt) { f32x4 acc = (f32x4){0.f, 0.f, 0.f, 0.f};
#pragma unroll
                for (int kc = 0; kc < 4; ++kc) acc = __builtin_amdgcn_mfma_f32_16x16x32_bf16(*(const LAS bf16x8*)(KL + (pp * 128 + 16 * nt + j) * 272 + (8 * g4 + 32 * kc) * 2), bq[kc], acc, 0, 0, 0);
#pragma unroll
                for (int e = 0; e < 4; ++e) topk_insert(v, (sort_key(acc[e]) & ~127) | (127 - (16 * nt + 4 * g4 + e))); }
            topk_merge16(v, 16); topk_merge16(v, 32);
#pragma unroll
            for (int i = 0; i < 16; ++i) { if (pp == 0) K1[i] = v[i]; else K2[i] = v[i]; }
        }
        float s1[16], s2[16];
#pragma unroll
        for (int a = 0; a < 16; ++a) { s1[a] = key_val(K1[a], 127); s2[a] = key_val(K2[a], 127); }
        int v2[16];
#pragma unroll
        for (int i = 0; i < 16; ++i) v2[i] = (int)0x80000000;
#pragma unroll
        for (int a = 0; a < 16; ++a)
#pragma unroll
            for (int b = 0; b < 16; ++b) if ((a + 1) * (b + 1) <= 16) topk_insert(v2, (sort_key(s1[a] + s2[b]) & ~255) | (255 - (16 * a + b)));
        if (g4 == 0) {
#pragma unroll
            for (int i = 0; i < 16; ++i) { TK[i] = K1[i]; TK[16 + i] = K2[i]; } }
        __builtin_amdgcn_fence(__ATOMIC_RELEASE, "wavefront"); __builtin_amdgcn_wave_barrier(); __builtin_amdgcn_fence(__ATOMIC_ACQUIRE, "wavefront");
        float ts[16]; int ex[16]; float mx = -3.0e38f;
#pragma unroll
        for (int k = 0; k < 16; ++k) { const int pos = 255 - (v2[k] & 255), a = pos >> 4, b = pos & 15; const int ka = TK[a], kb = TK[16 + b];
            ts[k] = key_val(ka, 127) + key_val(kb, 127); ex[k] = (127 - (ka & 127)) * 128 + (127 - (kb & 127)); mx = fmaxf(mx, ts[k]); }
        float sum = 0.f;
#pragma unroll
        for (int k = 0; k < 16; ++k) { ts[k] = fexp(ts[k] - mx); sum += ts[k]; }
        const float inv = 1.0f / sum; const size_t o = (tok * 8 + h) * 16;
        if (g4 == 0) {
#pragma unroll
            for (int k = 0; k < 16; k += 4) { *(u32x2*)(IDXW + (o + k) / 2) = (u32x2){(unsigned)ex[k] | ((unsigned)ex[k + 1] << 16), (unsigned)ex[k + 2] | ((unsigned)ex[k + 3] << 16)}; *(f32x4*)(GATE + o + k) = (f32x4){ts[k] * inv, ts[k + 1] * inv, ts[k + 2] * inv, ts[k + 3] * inv}; } }
        __builtin_amdgcn_wave_barrier();
    }
    WG_SYNC();
}

template <int CTRL> __device__ __forceinline__ float dpp_f(float v) { return __builtin_bit_cast(float, __builtin_amdgcn_update_dpp(0, __builtin_bit_cast(int, v), CTRL, 0xF, 0xF, true)); }
struct PItem { int js, t; bool valid; };
__device__ __forceinline__ PItem peer_item(int k, int c, int G, int w) { int it = c + k * G; PItem r; r.valid = it < 8 * 2048; if (!r.valid) it = c; r.js = it & 7; r.t = (it >> 3) * 8 + w; return r; }
__device__ __forceinline__ f32x2 cvt8(unsigned w, bool hi) { return hi ? __builtin_amdgcn_cvt_pk_f32_fp8((int)w, true) : __builtin_amdgcn_cvt_pk_f32_fp8((int)w, false); }

template <int CTRL> __device__ __forceinline__ int dpp_i(int v) { return __builtin_amdgcn_update_dpp(0, v, CTRL, 0xF, 0xF, true); }
__device__ __forceinline__ void pu_rows(const unsigned char* U8L, const unsigned char* XQ, const PItem& I, int sub, int grp, unsigned epk, uint4 (&d)[16], uint4& x0) {
    const unsigned char* base = U8L + (size_t)I.js * NEXP * 128;
#pragma unroll
    for (int i = 0; i < 16; ++i) { const unsigned e = ((unsigned)__shfl((int)epk, 8 * (i >> 1) + grp) >> (16 * (i & 1))) & 0xffffu; d[i] = *(const uint4*)(base + (size_t)e * 128); }
    x0 = *(const uint4*)(XQ + (size_t)I.t * DM + 128 * I.js + 16 * sub);
}
__device__ __forceinline__ void pu_compute(const uint4 (&d)[16], const uint4 x0, float* HIDP, const PItem& I, int sub, int grp) {
    int s[16];
#pragma unroll
    for (int i = 0; i < 16; ++i) { int a = __builtin_amdgcn_sdot4((int)d[i].x, (int)x0.x, 0, false); a = __builtin_amdgcn_sdot4((int)d[i].y, (int)x0.y, a, false);
        a = __builtin_amdgcn_sdot4((int)d[i].z, (int)x0.z, a, false); s[i] = __builtin_amdgcn_sdot4((int)d[i].w, (int)x0.w, a, false); }
    const bool b2 = (sub & 4) != 0, b1 = (sub & 2) != 0, b0 = (sub & 1) != 0;
    int r[8], q4[4], f[2];
#pragma unroll
    for (int k = 0; k < 8; ++k) { const int keep = b2 ? s[8 + k] : s[k], send = b2 ? s[k] : s[8 + k]; r[k] = keep + dpp_i<0x141>(send); }
#pragma unroll
    for (int k = 0; k < 4; ++k) { const int keep = b1 ? r[4 + k] : r[k], send = b1 ? r[k] : r[4 + k]; q4[k] = keep + dpp_i<0x4E>(send); }
#pragma unroll
    for (int k = 0; k < 2; ++k) { const int keep = b0 ? q4[2 + k] : q4[k], send = b0 ? q4[k] : q4[2 + k]; f[k] = keep + dpp_i<0xB1>(send); }
    if (I.valid) *(unsigned*)((bf16_t*)HIDP + (size_t)I.js * T_TOK * 128 + (size_t)I.t * 128 + 16 * sub + 2 * grp) = cvt_pk_bf16((float)f[0], (float)f[1]);
}
__device__ __forceinline__ void peer_u_phase(const Params& p, int layer, int G, int c) {
    const int tid = opaque_tid(), lane = tid & 63, w = tid >> 6, sub = lane & 7, grp = lane >> 3;
    const unsigned char* XQ = p.ws + WS_XQ; const unsigned* IDXW = (const unsigned*)(p.ws + WS_IDX); float* HIDP = (float*)(p.ws + WS_HIDP);
    const unsigned char* U8L = p.ws + WS_U8 + (size_t)layer * 8 * NEXP * 128 + 16 * sub;
    const int nit = (8 * 2048 - c + G - 1) / G;
    uint4 dA[16], dB[16], xa0, xb0; unsigned ea, eb;
    PItem IA = peer_item(0, c, G, w), IB = peer_item(1, c, G, w), IC = peer_item(2, c, G, w), ID = peer_item(3, c, G, w);
    ea = IDXW[IA.t * 64 + lane]; eb = IDXW[IB.t * 64 + lane];
    pu_rows(U8L, XQ, IA, sub, grp, ea, dA, xa0); ea = IDXW[IC.t * 64 + lane];
    pu_rows(U8L, XQ, IB, sub, grp, eb, dB, xb0); eb = IDXW[ID.t * 64 + lane];
    for (int k = 0; k < nit; k += 2) {
        pu_compute(dA, xa0, HIDP, IA, sub, grp);
        pu_rows(U8L, XQ, IC, sub, grp, ea, dA, xa0); IA = IC; IC = peer_item(k + 4, c, G, w); ea = IDXW[IC.t * 64 + lane];
        pu_compute(dB, xb0, HIDP, IB, sub, grp);
        pu_rows(U8L, XQ, ID, sub, grp, eb, dB, xb0); IB = ID; ID = peer_item(k + 5, c, G, w); eb = IDXW[ID.t * 64 + lane];
    }
}
__device__ __forceinline__ void peer_w_phase(const Params& p, int layer, int G, int c) {
    const int tid = opaque_tid();
    const unsigned* IDXW = (const unsigned*)(p.ws + WS_IDX); const float* GATE = (const float*)(p.ws + WS_GATE); const float* HIDP = (const float*)(p.ws + WS_HIDP);
    const float* USC = (const float*)(p.ws + WS_USC) + layer * NEXP; const float* VSC = (const float*)(p.ws + WS_VSC) + layer * NEXP; unsigned* EW = (unsigned*)(p.ws + WS_EW); const float* XSC = (const float*)(p.ws + WS_XSC);
    for (int i = (c * 512 + tid) * 4; i < T_TOK * 128; i += G * 512 * 4) { const u32x2 e2 = *(const u32x2*)(IDXW + i / 2); const f32x4 g = *(const f32x4*)(GATE + i); f32x4 h = (f32x4){0.f, 0.f, 0.f, 0.f};
#pragma unroll
        for (int j = 0; j < 8; ++j) { const u32x2 hb = *(const u32x2*)((const bf16_t*)HIDP + (size_t)j * T_TOK * 128 + i); h += (f32x4){bflo(hb.x), bfhi(hb.x), bflo(hb.y), bfhi(hb.y)}; }
        const int ev[4] = {(int)(e2.x & 0xffffu), (int)(e2.x >> 16), (int)(e2.y & 0xffffu), (int)(e2.y >> 16)}; unsigned ow[4]; const float xs = XSC[i >> 7];
#pragma unroll
        for (int q = 0; q < 4; ++q) ow[q] = ((unsigned)ev[q] << 16) | (cvt_pk_bf16(g[q] * fgelu_tanh(h[q] * (USC[ev[q]] * xs)) * VSC[ev[q]], 0.f) & 0xffffu);
        *(u32x4*)(EW + i) = (u32x4){ow[0], ow[1], ow[2], ow[3]}; }
}
__device__ __forceinline__ void pv_rows(const unsigned char* V8L, const float* xsrc, const PItem& I, int sub, int grp, int qoff, const unsigned ew0, const unsigned ew1, uint4 (&d)[16], unsigned (&wp)[16], f32x2& xr) {
    const unsigned char* base = V8L + (size_t)I.js * NEXP * 128;
#pragma unroll
    for (int i = 0; i < 16; ++i) { const unsigned pk = (unsigned)__shfl((int)(i < 8 ? ew0 : ew1), (8 * i + grp) & 63); wp[i] = pk; d[i] = *(const uint4*)(base + (size_t)(pk >> 16) * 128); }
    xr = *(const f32x2*)(xsrc + (size_t)I.t * DM + 128 * I.js + 16 * sub + qoff);
}
__device__ __forceinline__ void pv_compute(const uint4 (&d)[16], const unsigned (&wp)[16], const f32x2 xr, float* out, const PItem& I, int sub, int grp, int qoff, bool dryv) {
    f32x2 acc[8];
#pragma unroll
    for (int m = 0; m < 8; ++m) acc[m] = (f32x2){0.f, 0.f};
#pragma unroll
    for (int i = 0; i < 16; ++i) { const float wv = __uint_as_float(wp[i] << 16); const unsigned wq[4] = {d[i].x, d[i].y, d[i].z, d[i].w}; const f32x2 w2 = (f32x2){wv, wv};
#pragma unroll
        for (int q = 0; q < 4; ++q) { acc[2 * q] += w2 * cvt8(wq[q], false); acc[2 * q + 1] += w2 * cvt8(wq[q], true); } }
    float a[16];
#pragma unroll
    for (int m = 0; m < 8; ++m) { a[2 * m] = acc[m].x; a[2 * m + 1] = acc[m].y; }
    const bool b3 = (grp & 1) != 0, b4 = (grp & 2) != 0, b5 = (grp & 4) != 0;
    float r[8], q4[4], f[2];
#pragma unroll
    for (int k = 0; k < 8; ++k) { const float keep = b3 ? a[8 + k] : a[k], send = b3 ? a[k] : a[8 + k]; r[k] = keep + dpp_f<0x128>(send); }
#pragma unroll
    for (int k = 0; k < 4; ++k) { const float keep = b4 ? r[4 + k] : r[k], send = b4 ? r[k] : r[4 + k]; q4[k] = keep + __shfl_xor(send, 16); }
#pragma unroll
    for (int k = 0; k < 2; ++k) { const float keep = b5 ? q4[2 + k] : q4[k], send = b5 ? q4[k] : q4[2 + k]; f[k] = keep + __shfl_xor(send, 32); }
    if (I.valid && !dryv) *(f32x2*)(out + (size_t)I.t * DM + 128 * I.js + 16 * sub + qoff) = xr + (f32x2){f[0], f[1]};
}
__device__ __forceinline__ void peer_v_phase(const Params& p, int layer, const float* xsrc, int G, int c, bool dryv = false) {
    const int tid = opaque_tid(), lane = tid & 63, w = tid >> 6, sub = lane & 7, grp = lane >> 3;
    const unsigned char* V8L = p.ws + WS_V8 + (size_t)layer * 8 * NEXP * 128 + 16 * sub;
    const int qoff = 8 * (grp & 1) + 4 * ((grp >> 1) & 1) + 2 * (grp >> 2);
    const int nit = (8 * 2048 - c + G - 1) / G;
    uint4 dA[16], dB[16]; unsigned ea0, ea1, eb0, eb1, wpA[16], wpB[16]; f32x2 xra, xrb;
    const unsigned* EWu = (const unsigned*)(p.ws + WS_EW);
    PItem IA = peer_item(0, c, G, w), IB = peer_item(1, c, G, w), IC = peer_item(2, c, G, w), ID = peer_item(3, c, G, w);
    ea0 = EWu[IA.t * 128 + lane]; ea1 = EWu[IA.t * 128 + 64 + lane]; eb0 = EWu[IB.t * 128 + lane]; eb1 = EWu[IB.t * 128 + 64 + lane];
    pv_rows(V8L, xsrc, IA, sub, grp, qoff, ea0, ea1, dA, wpA, xra); ea0 = EWu[IC.t * 128 + lane]; ea1 = EWu[IC.t * 128 + 64 + lane];
    pv_rows(V8L, xsrc, IB, sub, grp, qoff, eb0, eb1, dB, wpB, xrb); eb0 = EWu[ID.t * 128 + lane]; eb1 = EWu[ID.t * 128 + 64 + lane];
    for (int k = 0; k < nit; k += 2) {
        pv_compute(dA, wpA, xra, p.out, IA, sub, grp, qoff, dryv);
        pv_rows(V8L, xsrc, IC, sub, grp, qoff, ea0, ea1, dA, wpA, xra); IA = IC; IC = peer_item(k + 4, c, G, w); ea0 = EWu[IC.t * 128 + lane]; ea1 = EWu[IC.t * 128 + 64 + lane];
        pv_compute(dB, wpB, xrb, p.out, IB, sub, grp, qoff, dryv);
        pv_rows(V8L, xsrc, ID, sub, grp, qoff, eb0, eb1, dB, wpB, xrb); IB = ID; ID = peer_item(k + 5, c, G, w); eb0 = EWu[ID.t * 128 + lane]; eb1 = EWu[ID.t * 128 + 64 + lane];
    }
}

#ifndef MK_PER_PHASE
#define MK_PER_PHASE 0
#endif
constexpr int PPL = 13;
constexpr int N_PHASES = 1 + PPL * NLAYER;

__global__ void __launch_bounds__(512, 2) mega_fwd(Params p) {
    extern __shared__ __attribute__((aligned(16))) unsigned char lds_raw[];
    LAS unsigned char* L = (LAS unsigned char*)lds_raw;
    const int G = (int)gridDim.x, c = (int)blockIdx.x;
    volatile LAS unsigned* st = (volatile LAS unsigned*)(L + LDS_MISC);
    if (threadIdx.x < 4) st[threadIdx.x] = 0u;
    __syncthreads();
    const int lo = p.ph_lo, hi = p.ph_hi;
    XcdBarrier bar; bar.bar = (unsigned*)(p.ws + WS_CTL); bar.x = 0; bar.st = st;
    if (hi - lo > 1) bar = xcd_barrier_post((unsigned*)(p.ws + WS_CTL), st);
#ifndef MK_ONLY
#define MK_ONLY -1
#endif
#define IN(k) (lo <= (k) && (k) < hi)
#define KIND(q) (MK_ONLY < 0 || MK_ONLY == (q))
#ifndef MK_TWICE
#define MK_TWICE -1
#endif
#define REP(q) for (int rep_ = 0; rep_ < ((MK_TWICE == (q)) ? 2 : 1); ++rep_)
#define SEAM(k) do { if (IN(k) && IN((k) + 1)) { xcd_barrier(bar); if (MK_TWICE == 30) xcd_barrier(bar); } } while (0)
    unsigned char* ws = p.ws;
    bf16_t* P = (bf16_t*)(ws + WS_P); bf16_t* H = (bf16_t*)(ws + WS_H);

    if (IN(0) && KIND(0)) REP(0) prologue_phase(p, L, G, c);
    SEAM(0);
    for (int l = 0; l < NLAYER; ++l) {
        const int pb = 1 + PPL * l;
        if (IN(pb + 0) && KIND(1)) REP(1) { Gemm g{H, (const bf16_t*)(ws + WS_WIN + (size_t)l * NP * 1024), T_TOK, NP, 512, 512, 512}; StaticOrder S; S.init(T_TOK, NP, G, c);
            pg8::EpiIn E{P, p.alpha_b + l * 256, (const float*)(ws + WS_WSC) + (size_t)l * NP, (const float*)(ws + WS_HSC)}; pg8::gemm_phase<pg8::EpiIn, StaticOrder, 2>(L, g, S, E, nullptr); }
        SEAM(pb + 0);
        if (IN(pb + 1) && KIND(2)) { if (MK_TWICE == 20) attn_phase(p, L, l, false, G, c, p.ph_lo == 0); attn_phase(p, L, l, false, G, c); if (MK_TWICE == 21) gla_a_phase(p, L, G, c); gla_a_phase(p, L, G, c); }
        SEAM(pb + 1);
        if (IN(pb + 2) && KIND(3)) { if (MK_TWICE == 22) gla_scan_phase(p, G, c); gla_scan_phase(p, G, c); if (MK_TWICE == 23) attn_phase(p, L, l, true, G, c, p.ph_lo == 0); attn_phase(p, L, l, true, G, c); }
        SEAM(pb + 2);
        if (IN(pb + 3) && KIND(4)) { if (MK_TWICE == 24) gla_c_phase(p, L, l, G, c, p.ph_lo == 0); gla_c_phase(p, L, l, G, c); if (MK_TWICE == 25) combine_phase(p, G, c, p.ph_lo == 0); combine_phase(p, G, c); }
        SEAM(pb + 3);
        if (IN(pb + 4) && KIND(5)) REP(5) { Gemm g{P, (const bf16_t*)(ws + WS_WBR) + (size_t)l * 3 * 1024 * 512, T_TOK, 1024, 512, 64, 512, (size_t)T_TOK * 128}; MergeOrder S; S.init(T_TOK, 1024, G, c);
            pg8::EpiMerge E{P, H}; pg8::gemm_phase<pg8::EpiMerge, MergeOrder>(L, g, S, E, nullptr); }
        SEAM(pb + 4);
        if (IN(pb + 5) && KIND(6)) REP(6) { Gemm g{H, (const bf16_t*)(ws + WS_WOUT) + (size_t)l * 1024 * 1024, T_TOK, 1024, 1024, 1024, 1024}; StaticOrder S; S.init(T_TOK, 1024, G, c);
            pg8::EpiResid E{l == 0 ? p.x : (const float*)p.out, p.out}; pg8::gemm_phase<pg8::EpiResid, StaticOrder>(L, g, S, E, nullptr); }
        SEAM(pb + 5);
        if (IN(pb + 6) && KIND(7)) REP(7) rmsnorm_phase<2>(p.out, p.norm_ffn + l * 1024, ws + WS_XQ, G, c, (float*)(ws + WS_XSC));
        SEAM(pb + 6);
        if (IN(pb + 7) && KIND(8)) REP(8) { Gemm g{(const bf16_t*)(ws + WS_XQ), (const bf16_t*)(ws + WS_WQ + (size_t)l * 2048 * 1024), T_TOK, 2048, 512, 512, 512}; StaticOrder S; S.init(T_TOK, 2048, G, c);
            pg8::EpiBfI8 E{(bf16_t*)(ws + WS_QY), 2048, (const float*)(ws + WS_WQSC) + (size_t)l * 2048, (const float*)(ws + WS_XSC)}; pg8::gemm_phase<pg8::EpiBfI8, StaticOrder, 2>(L, g, S, E, nullptr); }
        SEAM(pb + 7);
        if (IN(pb + 8) && KIND(9)) REP(9) peer_topk_phase(p, L, l, G, c);
        SEAM(pb + 8);
        if (IN(pb + 9) && KIND(10)) REP(10) peer_u_phase(p, l, G, c);
        SEAM(pb + 9);
        if (IN(pb + 10) && KIND(11)) REP(11) peer_w_phase(p, l, G, c);
        SEAM(pb + 10);
        if (IN(pb + 11) && KIND(12)) { if (MK_TWICE == 26) peer_v_phase(p, l, p.out, G, c, p.ph_lo == 0); peer_v_phase(p, l, p.out, G, c); }
        SEAM(pb + 11);
        if (IN(pb + 12) && KIND(13)) REP(13) { if (l + 1 < NLAYER) rmsnorm_phase<2>(p.out, p.norm_mix + (l + 1) * 1024, H, G, c, (float*)(ws + WS_HSC)); else rmsnorm_phase<0>(p.out, p.norm_final, p.out, G, c); }
        SEAM(pb + 12);
    }
#undef IN
#undef SEAM
}

extern "C" void kernel_launch(void* const* d_in, const int* in_sizes, int n_in, void* d_out, int out_size, void* d_ws, size_t ws_size, hipStream_t stream) {
    static int grid = 0;
    if (grid == 0) {
        if (n_in != 16 || out_size != T_TOK * DM || ws_size < WS_END) { fprintf(stderr, "kernel_launch: unexpected shapes (n_in %d, out %d, ws %zu < %zu)\n", n_in, out_size, ws_size, (size_t)WS_END); grid = -1; return; }
        int dev = 0, cus = 0, per_cu = 0;
        if (hipGetDevice(&dev) != hipSuccess || hipDeviceGetAttribute(&cus, hipDeviceAttributeMultiprocessorCount, dev) != hipSuccess) { grid = -1; return; }
        if (hipFuncSetAttribute((const void*)mega_fwd, hipFuncAttributeMaxDynamicSharedMemorySize, LDS_BYTES) != hipSuccess) { fprintf(stderr, "kernel_launch: hipFuncSetAttribute failed\n"); grid = -1; return; }
        if (hipOccupancyMaxActiveBlocksPerMultiprocessor(&per_cu, (const void*)mega_fwd, 512, LDS_BYTES) != hipSuccess || per_cu < 1) { fprintf(stderr, "kernel_launch: occupancy query says %d\n", per_cu); (void)hipGetLastError(); grid = -1; return; }
        grid = cus;
    }
    if (grid < 0) return;
    (void)hipMemsetAsync((char*)d_ws + WS_CTL, 0, CTL_BYTES, stream);
    Params p{};
    p.x = (const float*)d_in[0]; p.w_in = (const float*)d_in[1]; p.sinks = (const float*)d_in[2]; p.alpha_w = (const float*)d_in[3]; p.alpha_b = (const float*)d_in[4]; p.head_norm = (const float*)d_in[5];
    p.w_branch = (const float*)d_in[6]; p.w_out = (const float*)d_in[7]; p.norm_mix = (const float*)d_in[8]; p.norm_ffn = (const float*)d_in[9]; p.peer_wq = (const float*)d_in[10]; p.peer_keys = (const float*)d_in[11];
    p.peer_u = (const float*)d_in[12]; p.peer_v = (const float*)d_in[13]; p.rel_bias = (const float*)d_in[14]; p.norm_final = (const float*)d_in[15];
    p.out = (float*)d_out; p.ws = (unsigned char*)d_ws;
#if MK_PER_PHASE
    for (int k = 0; k < N_PHASES; ++k) { p.ph_lo = k; p.ph_hi = k + 1; hipLaunchKernelGGL(mega_fwd, dim3(grid), dim3(512), LDS_BYTES, stream, p); }
#else
    p.ph_lo = 0; p.ph_hi = N_PHASES;
    hipLaunchKernelGGL(mega_fwd, dim3(grid), dim3(512), LDS_BYTES, stream, p);
#endif
}
```
